# Optimizing an MI355X kernel written in HIP

```python
import jax, jax.numpy as jnp
from jax import lax
import numpy as np

D_MODEL = 2048
BATCH = 4
SEQ = 2048
DEPTH = 1
DEC_BATCH = 128
DEC_SEQ = 8
PAST_LEN = 2048
PAGE_SIZE = 128

RET_HEADS = 4
RET_DK = 256
RET_DV = 256
RET_WIDTH = RET_HEADS * RET_DV
RET_CHUNK = 128
NSA_HEADS = 16
NSA_KV = 4
NSA_REP = NSA_HEADS // NSA_KV
HEAD_DIM = 64
NSA_WIDTH = NSA_HEADS * HEAD_DIM
CMP_LEN = 32
CMP_STRIDE = 16
CMP_HIDDEN = 256
SEL_BLK = 64
SEL_TOPK = 16
WINDOW = 512
WIN_QBLK = 128
SEL_QBLK = 32
SCALE = HEAD_DIM ** -0.5
D_MIX = RET_WIDTH + NSA_WIDTH
SPLITS = (RET_HEADS * RET_DK, RET_HEADS * RET_DK, RET_WIDTH, RET_WIDTH, NSA_WIDTH, 6 * NSA_KV * HEAD_DIM, 3 * NSA_HEADS)
D_IN = sum(SPLITS)
D_FF = 5632
CONV_W = 3
EPS = 1e-6

kernel_name = 'retnet_nsa_hymba_convffn_step'


def _rms(x, g):
    xf = x.astype(jnp.float32)
    y = xf * lax.rsqrt(jnp.mean(xf * xf, axis=-1, keepdims=True) + EPS)
    return (y * g.astype(jnp.float32)).astype(x.dtype)


def _masked_softmax(s, valid):
    s = jnp.where(valid, s, -jnp.inf)
    m = jnp.max(s, axis=-1, keepdims=True)
    m = jnp.where(jnp.isfinite(m), m, 0.0)
    e = jnp.where(valid, jnp.exp(s - m), 0.0)
    return e / jnp.maximum(jnp.sum(e, axis=-1, keepdims=True), 1e-30)


def _alibi_slopes():
    h = jnp.arange(1, NSA_HEADS + 1, dtype=jnp.float32)
    return jnp.exp2(-8.0 * h / NSA_HEADS).reshape(NSA_KV, NSA_REP)


def _rotate(x, pos):
    half = x.shape[-1] // 2
    inv = 1.0 / (10000.0 ** jnp.linspace(0.0, 1.0, half, dtype=jnp.float32))
    ang = pos.astype(jnp.float32)[:, None] * inv[None, :]
    cos = jnp.cos(ang)[:, None, :]
    sin = jnp.sin(ang)[:, None, :]
    xf = x.astype(jnp.float32)
    x1, x2 = xf[..., :half], xf[..., half:]
    return jnp.concatenate([x1 * cos - x2 * sin, x2 * cos + x1 * sin], axis=-1).astype(x.dtype)


def _retention(q, k, v, state0, chunk):
    B, T, H, DK = q.shape
    DV = v.shape[-1]
    n = T // chunk
    lg = jnp.log(1.0 - jnp.exp2(-5.0 - jnp.arange(H, dtype=jnp.float32)))
    i = jnp.arange(chunk, dtype=jnp.float32)
    diff = i[:, None] - i[None, :]
    dmask = jnp.where(diff >= 0, jnp.exp(lg[:, None, None] * jnp.maximum(diff, 0.0)), 0.0)
    xi = jnp.exp(lg[None, :] * (i[:, None] + 1.0))
    zeta = jnp.exp(lg[None, :] * (chunk - 1.0 - i[:, None]))
    g_chunk = jnp.exp(lg * chunk)

    def to_chunks(a):
        return a.astype(jnp.float32).reshape(B, n, chunk, H, a.shape[-1]).swapaxes(0, 1)

    def step(S, inp):
        qi, ki, vi = inp
        s = jnp.einsum('bihd,bjhd->bhij', qi, ki) * dmask
        o = jnp.einsum('bhij,bjhe->bihe', s, vi) + jnp.einsum('bihd,bhde->bihe', qi, S) * xi[:, :, None]
        S = S * g_chunk[:, None, None] + jnp.einsum('bjhd,bjhe->bhde', ki * zeta[:, :, None], vi)
        return S, o

    S, o = lax.scan(step, state0.astype(jnp.float32), (to_chunks(q), to_chunks(k), to_chunks(v)))
    return o.swapaxes(0, 1).reshape(B, T, H, DV).astype(q.dtype), S


def _block_cover(n_cmp, n_sel):
    cs = np.arange(n_cmp)[:, None] * CMP_STRIDE
    js = np.arange(n_sel)[None, :] * SEL_BLK
    cov = np.clip(np.minimum(cs + CMP_LEN, js + SEL_BLK) - np.maximum(cs, js), 0, None)
    return jnp.asarray(cov / CMP_LEN, dtype=jnp.float32)


def _compress(kv_raw, pe, w1, b1, w2, b2):
    B, Tk = kv_raw.shape[:2]
    n_half = Tk // CMP_STRIDE
    hb = kv_raw[:, :n_half * CMP_STRIDE].reshape(B, n_half, CMP_STRIDE, 2, NSA_KV, HEAD_DIM)
    pe = pe.reshape(2, 2, CMP_STRIDE, HEAD_DIM)
    w1 = w1.reshape(2, 2, CMP_STRIDE, HEAD_DIM, CMP_HIDDEN)

    def half(j):
        pej = pe[:, j].transpose(1, 0, 2)[:, :, None, :]
        return jnp.einsum('bnlcgd,cldh->bncgh', hb + pej, w1[:, j])

    hid = jax.nn.silu(half(0)[:, :-1] + half(1)[:, 1:] + b1[:, None, :])
    return jnp.einsum('bncgh,chd->bncgd', hid, w2) + b2[:, None, :]


def _band_attend(q, qpos, k, v, kpos):
    slopes = _alibi_slopes()
    dist = qpos[:, None] - kpos[None, :]
    valid = (kpos[None, :] >= 0) & (dist >= 0) & (dist < WINDOW)
    s = jnp.einsum('bqgrd,bsgd->bgrqs', q, k).astype(jnp.float32) * SCALE \
        - slopes[None, :, :, None, None] * dist.astype(jnp.float32)
    p = _masked_softmax(s, valid)
    return jnp.einsum('bgrqs,bsgd->bqgrd', p.astype(v.dtype), v)


def _window_prompt(q, win):
    B, T = q.shape[:2]
    nb = T // WIN_QBLK
    kp = jnp.pad(win, ((0, 0), (WINDOW, 0), (0, 0), (0, 0), (0, 0)))
    qb = q.reshape((B, nb, WIN_QBLK) + q.shape[2:]).swapaxes(0, 1)
    starts = jnp.arange(nb) * WIN_QBLK

    def blk(args):
        qi, st = args
        ctx = lax.dynamic_slice_in_dim(kp, st, WINDOW + WIN_QBLK, axis=1)
        return _band_attend(qi, st + jnp.arange(WIN_QBLK), ctx[:, :, 0], ctx[:, :, 1],
                            st - WINDOW + jnp.arange(WINDOW + WIN_QBLK))

    o = lax.map(blk, (qb, starts))
    return o.swapaxes(0, 1).reshape(q.shape)


def _nsa_cmp_sel(q, q0, rows, sel_qblk, p):
    B, Tq = q.shape[:2]
    Tk = rows.shape[1]
    slopes = _alibi_slopes()
    qpos = q0 + jnp.arange(Tq)
    cmp = _compress(rows[:, :, 0:2], p['cmp_pe'], p['cmp_w1'], p['cmp_b1'], p['cmp_w2'], p['cmp_b2'])
    kc = _rms(cmp[:, :, 0], p['k_norm_cmp'])
    vc = cmp[:, :, 1]
    n_cmp = kc.shape[1]
    cend = jnp.arange(n_cmp) * CMP_STRIDE + (CMP_LEN - 1)
    dist = qpos[:, None] - cend[None, :]
    s = jnp.einsum('btgrd,bngd->bgrtn', q, kc).astype(jnp.float32) * SCALE \
        - slopes[None, :, :, None, None] * dist.astype(jnp.float32)
    pc = _masked_softmax(s, dist >= 0)
    o_cmp = jnp.einsum('bgrtn,bngd->btgrd', pc.astype(vc.dtype), vc)
    n_sel = -(-Tk // SEL_BLK)
    k_sel = min(SEL_TOPK, n_sel)
    imp = jnp.einsum('bgrtn,nj->btgj', pc, _block_cover(n_cmp, n_sel))
    j = jnp.arange(n_sel)[None, :]
    cur = (qpos // SEL_BLK)[:, None]
    valid_j = (j <= cur)[None, :, None, :]
    forced = ((j == 0) | (j == cur) | (j == cur - 1))[None, :, None, :]
    score = jnp.where(valid_j, jnp.where(forced, jnp.inf, imp), -jnp.inf)
    top_val, top_idx = lax.top_k(score, k_sel)
    top_ok = top_val > -jnp.inf
    pad = n_sel * SEL_BLK - Tk

    def blocks(a):
        a = jnp.pad(a, ((0, 0), (0, pad), (0, 0), (0, 0)))
        return a.reshape(B, n_sel, SEL_BLK, NSA_KV, HEAD_DIM).transpose(0, 3, 1, 2, 4)

    kb = blocks(rows[:, :, 2])
    vb = blocks(rows[:, :, 3])
    nqb = Tq // sel_qblk

    def split_q(a):
        return a.reshape((B, nqb, sel_qblk) + a.shape[2:]).swapaxes(0, 1)

    bi = jnp.arange(B)[:, None, None, None]
    gi = jnp.arange(NSA_KV)[None, None, :, None]

    def sel_block(args):
        qi, ii, oki, pi = args
        kg = kb[bi, gi, ii]
        vg = vb[bi, gi, ii]
        kpos = ii[..., None] * SEL_BLK + jnp.arange(SEL_BLK)
        d = pi[None, :, None, None, None] - kpos
        ok = (oki[..., None] & (d >= 0))[:, :, :, None]
        sc = jnp.einsum('bqgrd,bqgkld->bqgrkl', qi, kg).astype(jnp.float32) * SCALE \
            - slopes[None, None, :, :, None, None] * d[:, :, :, None].astype(jnp.float32)
        shp = sc.shape
        flat = shp[:4] + (shp[4] * shp[5],)
        pr = _masked_softmax(sc.reshape(flat), jnp.broadcast_to(ok, shp).reshape(flat)).reshape(shp)
        return jnp.einsum('bqgrkl,bqgkld->bqgrd', pr.astype(vg.dtype), vg)

    o_sel = lax.map(sel_block, (split_q(q), split_q(top_idx), split_q(top_ok), qpos.reshape(nqb, sel_qblk)))
    return o_cmp, o_sel.swapaxes(0, 1).reshape(q.shape)


def _project(x, pos, p):
    B, T = x.shape[:2]
    z = _rms(x, p['g_attn']) @ p['w_in']
    points = [int(c) for c in np.cumsum(SPLITS)[:-1]]
    rq, rk, rv, rg, nq, nkv, ng = jnp.split(z, points, axis=-1)
    rq = _rotate(rq.reshape(B, T, RET_HEADS, RET_DK), pos)
    rk = _rotate(rk.reshape(B, T, RET_HEADS, RET_DK), pos) * (RET_DK ** -0.5)
    rv = rv.reshape(B, T, RET_HEADS, RET_DV)
    nq = _rms(nq.reshape(B, T, NSA_KV, NSA_REP, HEAD_DIM), p['q_norm'])
    nkv = nkv.reshape(B, T, 6, NSA_KV, HEAD_DIM)
    k_slc = _rms(nkv[:, :, 2], p['k_norm_slc'])
    k_win = _rms(nkv[:, :, 4], p['k_norm_win'])
    rows = jnp.stack([nkv[:, :, 0], nkv[:, :, 1], k_slc, nkv[:, :, 3]], axis=2)
    win = jnp.stack([k_win, nkv[:, :, 5]], axis=2)
    gates = jax.nn.sigmoid(ng.reshape(B, T, NSA_KV, NSA_REP, 3))
    return rq, rk, rv, rg, nq, rows, win, gates


def _mixer_out(x, ret_o, rg, o_cmp, o_sel, o_win, gates, p):
    B, T = x.shape[:2]
    ret = _rms(ret_o, p['ret_gn']) * jax.nn.silu(rg.reshape(ret_o.shape))
    nsa = gates[..., 0:1] * o_cmp + gates[..., 1:2] * o_sel + gates[..., 2:3] * o_win
    mix = jnp.concatenate([ret.reshape(B, T, RET_WIDTH), nsa.reshape(B, T, NSA_WIDTH)], axis=-1)
    return x + mix @ p['w_out']


def _conv_ffn(x, prev, p):
    T = x.shape[1]
    u = _rms(x, p['g_ffn']) @ p['w_up']
    up = jnp.concatenate([prev.astype(u.dtype), u], axis=1)
    c = p['conv_b'] + p['conv_w'][CONV_W - 1] * up[:, CONV_W - 1:]
    for j in range(CONV_W - 1):
        c = c + p['conv_w'][j] * up[:, j:j + T]
    a, b = jnp.split(c, 2, axis=-1)
    return x + (jax.nn.silu(a) * b) @ p['w_down'], up[:, T:]


def _layer_prompt(x, p):
    B, T = x.shape[:2]
    pos = jnp.arange(T)
    rq, rk, rv, rg, nq, rows, win, gates = _project(x, pos, p)
    s0 = jnp.zeros((B, RET_HEADS, RET_DK, RET_DV), jnp.float32)
    ret_o, ret_s = _retention(rq, rk, rv, s0, min(RET_CHUNK, T))
    o_cmp, o_sel = _nsa_cmp_sel(nq, 0, rows, SEL_QBLK, p)
    o_win = _window_prompt(nq, win)
    h = _mixer_out(x, ret_o, rg, o_cmp, o_sel, o_win, gates, p)
    y, conv_s = _conv_ffn(h, jnp.zeros((B, CONV_W - 1, 2 * D_FF), h.dtype), p)
    return y, rows, win[:, -min(WINDOW, T):], ret_s, conv_s


def _layer_sample(x, cache_kv, cache_win, state_ret, state_conv, page_table, p):
    B, T = x.shape[:2]
    past = page_table.shape[1] * cache_kv.shape[1]
    pos = past + jnp.arange(T)
    rq, rk, rv, rg, nq, rows, win, gates = _project(x, pos, p)
    hist = cache_kv[page_table].reshape((B, past) + cache_kv.shape[2:])
    full = jnp.concatenate([hist.astype(rows.dtype), rows], axis=1)
    ret_o, ret_s = _retention(rq, rk, rv, state_ret, T)
    o_cmp, o_sel = _nsa_cmp_sel(nq, past, full, 1, p)
    wb = cache_win.shape[1]
    ctx = jnp.concatenate([cache_win.astype(win.dtype), win], axis=1)
    o_win = _band_attend(nq, pos, ctx[:, :, 0], ctx[:, :, 1], past - wb + jnp.arange(wb + T))
    h = _mixer_out(x, ret_o, rg, o_cmp, o_sel, o_win, gates, p)
    y, conv_s = _conv_ffn(h, state_conv, p)
    return y, rows, ctx[:, T:], ret_s, conv_s


def setup_inputs(seed: int = 0) -> dict:
    key = jax.random.key(seed)
    ks = iter(jax.random.split(key, 32))

    def nrm(shape, scale):
        return jax.random.normal(next(ks), shape, jnp.float32) * scale

    n_pages = PAST_LEN // PAGE_SIZE
    n_used = DEC_BATCH * n_pages
    n_pool = n_used + max(1, n_used // 4)
    win_buf = min(WINDOW, PAST_LEN)
    L = DEPTH
    return {
        'x_prompt': nrm((BATCH, SEQ, D_MODEL), 1.0),
        'x_sample': nrm((DEC_BATCH, DEC_SEQ, D_MODEL), 1.0),
        'cache_kv': nrm((L, n_pool, PAGE_SIZE, 4, NSA_KV, HEAD_DIM), 1.0),
        'cache_win': nrm((L, DEC_BATCH, win_buf, 2, NSA_KV, HEAD_DIM), 1.0),
        'state_ret': nrm((L, DEC_BATCH, RET_HEADS, RET_DK, RET_DV), 0.5),
        'state_conv': nrm((L, DEC_BATCH, CONV_W - 1, 2 * D_FF), 1.0),
        'page_table': jax.random.permutation(next(ks), n_pool)[:n_used].reshape(DEC_BATCH, n_pages).astype(jnp.int32),
        'g_attn': 1.0 + nrm((L, D_MODEL), 0.1),
        'w_in': nrm((L, D_MODEL, D_IN), D_MODEL ** -0.5),
        'q_norm': 1.0 + nrm((L, HEAD_DIM), 0.1),
        'k_norm_cmp': 1.0 + nrm((L, HEAD_DIM), 0.1),
        'k_norm_slc': 1.0 + nrm((L, HEAD_DIM), 0.1),
        'k_norm_win': 1.0 + nrm((L, HEAD_DIM), 0.1),
        'cmp_pe': nrm((L, 2, CMP_LEN, HEAD_DIM), 0.5),
        'cmp_w1': nrm((L, 2, CMP_LEN, HEAD_DIM, CMP_HIDDEN), (CMP_LEN * HEAD_DIM) ** -0.5),
        'cmp_b1': nrm((L, 2, CMP_HIDDEN), 0.01),
        'cmp_w2': nrm((L, 2, CMP_HIDDEN, HEAD_DIM), CMP_HIDDEN ** -0.5),
        'cmp_b2': nrm((L, 2, HEAD_DIM), 0.01),
        'ret_gn': 1.0 + nrm((L, RET_HEADS, RET_DV), 0.1),
        'w_out': nrm((L, D_MIX, D_MODEL), D_MIX ** -0.5),
        'g_ffn': 1.0 + nrm((L, D_MODEL), 0.1),
        'w_up': nrm((L, D_MODEL, 2 * D_FF), D_MODEL ** -0.5),
        'conv_w': nrm((L, CONV_W, 2 * D_FF), CONV_W ** -0.5),
        'conv_b': nrm((L, 2 * D_FF), 0.01),
        'w_down': nrm((L, D_FF, D_MODEL), D_FF ** -0.5),
    }


def reference(x_prompt, x_sample, cache_kv, cache_win, state_ret, state_conv, page_table,
              g_attn, w_in, q_norm, k_norm_cmp, k_norm_slc, k_norm_win, cmp_pe, cmp_w1, cmp_b1,
              cmp_w2, cmp_b2, ret_gn, w_out, g_ffn, w_up, conv_w, conv_b, w_down):
    xp, xs = x_prompt, x_sample
    kv_p, kv_s, win_p, win_s, ret_p, ret_s, conv_p, conv_s = [], [], [], [], [], [], [], []
    for l in range(DEPTH):
        p = dict(g_attn=g_attn[l], w_in=w_in[l], q_norm=q_norm[l], k_norm_cmp=k_norm_cmp[l],
                 k_norm_slc=k_norm_slc[l], k_norm_win=k_norm_win[l], cmp_pe=cmp_pe[l], cmp_w1=cmp_w1[l],
                 cmp_b1=cmp_b1[l], cmp_w2=cmp_w2[l], cmp_b2=cmp_b2[l], ret_gn=ret_gn[l], w_out=w_out[l],
                 g_ffn=g_ffn[l], w_up=w_up[l], conv_w=conv_w[l], conv_b=conv_b[l], w_down=w_down[l])
        xp, a, b, c, d = _layer_prompt(xp, p)
        kv_p.append(a); win_p.append(b); ret_p.append(c); conv_p.append(d)
        xs, a, b, c, d = _layer_sample(xs, cache_kv[l], cache_win[l], state_ret[l], state_conv[l], page_table, p)
        kv_s.append(a); win_s.append(b); ret_s.append(c); conv_s.append(d)
    return (xp, xs, jnp.stack(kv_p), jnp.stack(kv_s), jnp.stack(win_p), jnp.stack(win_s),
            jnp.stack(ret_p), jnp.stack(ret_s), jnp.stack(conv_p), jnp.stack(conv_s))
```

```cpp
#include <hip/hip_runtime.h>
#include <cstdio>
#include <cstdint>
namespace pg8 {
#define PG8_LAS __attribute__((address_space(3)))
typedef unsigned short bf16_t;
typedef short bf16x8 __attribute__((ext_vector_type(8)));
typedef float f32x4 __attribute__((ext_vector_type(4)));
typedef unsigned u32x4 __attribute__((ext_vector_type(4)));
constexpr int BM = 256, BK = 64, HALF = 128, HTB = HALF * BK * 2  , STAGE_BYTES = 8 * HTB, NXCD = 8, WGM = 4;

__host__ __device__ __forceinline__ int lds_byte(int r, int c) { const int st = (r >> 4) * 2 + (c >> 5), rr = r & 15, cc = c & 31, ob = rr * 64 + cc * 2; return st * 1024 + (ob ^ (((ob >> 9) & 1) << 5)); }
__host__ __device__ __forceinline__ void stage_rc(int b, int& R, int& C) { const int st = b / 1024, sb = b % 1024, swz = sb ^ (((sb >> 9) & 1) << 5); R = (st >> 1) * 16 + swz / 64; C = (st & 1) * 32 + (swz % 64) / 2; }
__host__ __device__ __forceinline__ int perm32(int rho) { const int n = rho >> 4, i = rho & 15; return 8 * (i >> 2) + 4 * n + (i & 3); }

struct Unit { int pm, pn; };
struct Gemm { const bf16_t* A; const bf16_t* Bt; int M, N, K; };

struct StaticOrder {
    int nM, nN, nwg, G, c;
    __host__ __device__ void init(int M, int N, int G_, int c_) { nM = M / BM; nN = N / BM; nwg = nM * nN; G = G_; c = c_; }
    __host__ __device__ bool next(int i, Unit& u) const {
        const long L = (long)i * G + c; if (L >= nwg) return false;
        int wgid = (int)L; { const int q = nwg / NXCD, r = nwg % NXCD, xcd = wgid % NXCD, off = wgid / NXCD; wgid = (xcd < r ? xcd * (q + 1) : r * (q + 1) + (xcd - r) * q) + off; }
        const int nig = WGM * nN, gid = wgid / nig, fm = gid * WGM, gsz = (nM - fm) < WGM ? (nM - fm) : WGM;
        u.pm = fm + ((wgid % nig) % gsz); u.pn = (wgid % nig) / gsz; return true;
    }
    __device__ __forceinline__ void a_ready(const Unit&) const {}
    __device__ __forceinline__ void done(const Unit&) const {}
};
__device__ __forceinline__ unsigned cvt_pk_bf16(float lo, float hi) { unsigned r; asm volatile("v_cvt_pk_bf16_f32 %0, %1, %2" : "=v"(r) : "v"(lo), "v"(hi)); return r; }
template <class Epi, class Sched, bool ALIGN_EPI = false, bool SP2 = false>
__device__ __forceinline__ void gemm_phase(PG8_LAS unsigned char* lds, const Gemm g, const Sched& S, const Epi& E, const int wid) {
    int lane; asm volatile("v_mbcnt_lo_u32_b32 %0, -1, 0\n\tv_mbcnt_hi_u32_b32 %0, -1, %0" : "=v"(lane)); const int tid = wid * 64 + lane, wr = wid >> 2, wc = wid & 3, fr = lane & 15, fq = lane >> 4;
    const int K = g.K, nt = K / BK;
    unsigned voffA[2], voffB[2];
#pragma unroll
    for (int i = 0; i < 2; ++i) { int R, C; stage_rc(tid * 16 + i * 8192, R, C); const int Rb = Epi::PERM ? ((R & ~31) + perm32(R & 31)) : R;
        voffA[i] = (unsigned)(R * K + C) * 2u; voffB[i] = (unsigned)(Rb * K + C) * 2u; }
    const size_t kstep = (size_t)(BK * 2);
    const size_t hstep = (size_t)HALF * K * 2;
    const size_t tstep = 2 * hstep;
    const unsigned ldsw = (unsigned)wid * 1024u;
    const int aoff = lds_byte(wr * 64 + fr, fq * 8), boff = lds_byte(wc * 32 + fr, fq * 8);
#define PG8_SA(b, h) (((b) * 2 + (h)) * HTB)
#define PG8_SB(b, h) ((4 + (b) * 2 + (h)) * HTB)
#define PG8_STAGE(bufoff, gbase, voff) do { _Pragma("unroll") for (int _i = 0; _i < 2; ++_i) \
        __builtin_amdgcn_global_load_lds((const unsigned*)((const char*)(gbase) + (voff)[_i]), (PG8_LAS unsigned*)(lds + (bufoff) + ldsw + _i * 8192), 16, 0, 0); } while (0)
#define PG8_LDA(dst, b, h) do { _Pragma("unroll") for (int m = 0; m < 4; ++m) _Pragma("unroll") for (int k = 0; k < 2; ++k) dst[m][k] = *(const PG8_LAS bf16x8*)(lds + PG8_SA(b, h) + aoff + m * 2048 + k * 1024); } while (0)
#define PG8_LDB(dst, b, h) do { _Pragma("unroll") for (int n = 0; n < 2; ++n) _Pragma("unroll") for (int k = 0; k < 2; ++k) dst[n][k] = *(const PG8_LAS bf16x8*)(lds + PG8_SB(b, h) + boff + n * 2048 + k * 1024); } while (0)
#define PG8_MMA(ai, bj, At, Bt) do { __builtin_amdgcn_s_setprio(1); _Pragma("unroll") for (int m = 0; m < 4; ++m) _Pragma("unroll") for (int n = 0; n < 2; ++n) _Pragma("unroll") for (int k = 0; k < 2; ++k) \
        acc[ai][bj][m][n] = __builtin_amdgcn_mfma_f32_16x16x32_bf16(Bt[n][k], At[m][k], acc[ai][bj][m][n], 0, 0, 0); __builtin_amdgcn_s_setprio(0); } while (0)
#define PG8_WAIT_V(n) asm volatile("s_waitcnt vmcnt(" #n ")" ::: "memory")
#define PG8_WAIT_L(n) asm volatile("s_waitcnt lgkmcnt(" #n ")" ::: "memory")
#define PG8_BAR __builtin_amdgcn_s_barrier()
#define PG8_SCHED __builtin_amdgcn_sched_barrier(0)
    Unit cur, nxt; int ui = 0;
    if (!S.next(0, cur)) return;
    f32x4 acc[2][2][4][2];
#pragma unroll
    for (int a = 0; a < 2; ++a)
#pragma unroll
        for (int b = 0; b < 2; ++b)
#pragma unroll
            for (int m = 0; m < 4; ++m)
#pragma unroll
                for (int n = 0; n < 2; ++n) acc[a][b][m][n] = (f32x4){0.f, 0.f, 0.f, 0.f};
    bf16x8 At[4][2], B0[2][2], B1[2][2];
    const char* cA = (const char*)g.A + (size_t)cur.pm * tstep; const char* cB = (const char*)g.Bt + (size_t)cur.pn * tstep;
    S.a_ready(cur);
    if constexpr (SP2) {
        PG8_STAGE(PG8_SB(0, 0), cB, voffB); PG8_STAGE(PG8_SB(0, 1), cB + hstep, voffB); PG8_STAGE(PG8_SA(0, 0), cA, voffA); PG8_STAGE(PG8_SA(0, 1), cA + hstep, voffA);
        if (wr == 1) PG8_BAR;
        PG8_WAIT_V(2); PG8_BAR;
        PG8_STAGE(PG8_SB(1, 0), cB + kstep, voffB); PG8_STAGE(PG8_SA(1, 0), cA + kstep, voffA); PG8_STAGE(PG8_SB(1, 1), cB + hstep + kstep, voffB);
        PG8_WAIT_V(6); PG8_BAR;
    } else {
        PG8_STAGE(PG8_SB(0, 0), cB, voffB); PG8_STAGE(PG8_SA(0, 0), cA, voffA); PG8_STAGE(PG8_SB(0, 1), cB + hstep, voffB); PG8_STAGE(PG8_SA(0, 1), cA + hstep, voffA);
        if (wr == 1) PG8_BAR;
        PG8_WAIT_V(4); PG8_BAR;
        PG8_STAGE(PG8_SB(1, 0), cB + kstep, voffB); PG8_STAGE(PG8_SA(1, 0), cA + kstep, voffA); PG8_STAGE(PG8_SB(1, 1), cB + hstep + kstep, voffB);
        PG8_WAIT_V(6); PG8_BAR;
    }
    for (;;) {
        const bool has_next = S.next(ui + 1, nxt);
        const char* nA = has_next ? (const char*)g.A + (size_t)nxt.pm * tstep : cA; const char* nB = has_next ? (const char*)g.Bt + (size_t)nxt.pn * tstep : cB;
        for (int t = 0; t < nt; t += 2) {
            const bool last = (t == nt - 2);
            const char* a1 = cA + (size_t)(t + 1) * kstep;
            const char* a2 = last ? nA : cA + (size_t)(t + 2) * kstep; const char* b2 = last ? nB : cB + (size_t)(t + 2) * kstep;
            const char* a3 = a2 + kstep; const char* b3 = b2 + kstep;
            if (last && has_next) S.a_ready(nxt);
            if constexpr (SP2) {
            PG8_LDB(B0, 0, 0); PG8_LDB(B1, 0, 1); PG8_SCHED; PG8_LDA(At, 0, 0); PG8_STAGE(PG8_SA(1, 1), a1 + hstep, voffA);
            PG8_WAIT_V(8); PG8_WAIT_L(0); PG8_BAR; PG8_MMA(0, 0, At, B0); PG8_MMA(0, 1, At, B1); PG8_BAR; PG8_SCHED;
            PG8_LDA(At, 0, 1); PG8_STAGE(PG8_SB(0, 0), b2, voffB); PG8_STAGE(PG8_SB(0, 1), b2 + hstep, voffB); PG8_STAGE(PG8_SA(0, 0), a2, voffA);
            PG8_WAIT_V(8); PG8_WAIT_L(0); PG8_BAR; PG8_MMA(1, 0, At, B0); PG8_MMA(1, 1, At, B1); PG8_BAR; PG8_SCHED;
            PG8_LDB(B0, 1, 0); PG8_LDB(B1, 1, 1); PG8_SCHED; PG8_LDA(At, 1, 0); PG8_STAGE(PG8_SA(0, 1), a2 + hstep, voffA);
            PG8_WAIT_V(8); PG8_WAIT_L(0); PG8_BAR; PG8_MMA(0, 0, At, B0); PG8_MMA(0, 1, At, B1); PG8_BAR; PG8_SCHED;
            PG8_LDA(At, 1, 1); PG8_STAGE(PG8_SB(1, 0), b3, voffB); PG8_STAGE(PG8_SB(1, 1), b3 + hstep, voffB); PG8_STAGE(PG8_SA(1, 0), a3, voffA);
            PG8_WAIT_V(8); PG8_WAIT_L(0); PG8_BAR; PG8_MMA(1, 0, At, B0); PG8_MMA(1, 1, At, B1); PG8_BAR; PG8_SCHED;
            } else {
            PG8_LDB(B0, 0, 0); PG8_SCHED; PG8_LDA(At, 0, 0); PG8_STAGE(PG8_SA(1, 1), a1 + hstep, voffA);
            PG8_WAIT_L(8); PG8_BAR; PG8_WAIT_L(0); PG8_MMA(0, 0, At, B0); PG8_BAR; PG8_SCHED;
            PG8_LDB(B1, 0, 1); PG8_STAGE(PG8_SB(0, 0), b2, voffB);
            PG8_BAR; PG8_WAIT_L(0); PG8_MMA(0, 1, At, B1); PG8_BAR;
            PG8_LDA(At, 0, 1); PG8_STAGE(PG8_SA(0, 0), a2, voffA);
            PG8_BAR; PG8_WAIT_L(0); PG8_MMA(1, 0, At, B0); PG8_BAR; PG8_SCHED;
            PG8_STAGE(PG8_SB(0, 1), b2 + hstep, voffB);
            PG8_WAIT_V(6); PG8_BAR; PG8_MMA(1, 1, At, B1); PG8_BAR;
            PG8_LDB(B0, 1, 0); PG8_SCHED; PG8_LDA(At, 1, 0); PG8_STAGE(PG8_SA(0, 1), a2 + hstep, voffA);
            PG8_WAIT_L(8); PG8_BAR; PG8_WAIT_L(0); PG8_MMA(0, 0, At, B0); PG8_BAR; PG8_SCHED;
            PG8_LDB(B1, 1, 1); PG8_STAGE(PG8_SB(1, 0), b3, voffB);
            PG8_BAR; PG8_WAIT_L(0); PG8_MMA(0, 1, At, B1); PG8_BAR;
            PG8_LDA(At, 1, 1); PG8_STAGE(PG8_SA(1, 0), a3, voffA);
            PG8_BAR; PG8_WAIT_L(0); PG8_MMA(1, 0, At, B0); PG8_BAR; PG8_SCHED;
            PG8_STAGE(PG8_SB(1, 1), b3 + hstep, voffB);
            PG8_WAIT_V(6); PG8_BAR; PG8_MMA(1, 1, At, B1); PG8_BAR;
            }
        }
        if constexpr (ALIGN_EPI) { if (wr == 0) PG8_BAR; }
        if constexpr (!Epi::AFTER_DRAIN) { E(acc, cur, wr, wc, fr, fq); S.done(cur); }
        if (!has_next) break;
#pragma unroll
        for (int a = 0; a < 2; ++a)
#pragma unroll
            for (int b = 0; b < 2; ++b)
#pragma unroll
                for (int m = 0; m < 4; ++m)
#pragma unroll
                    for (int n = 0; n < 2; ++n) acc[a][b][m][n] = (f32x4){0.f, 0.f, 0.f, 0.f};
        cur = nxt; cA = nA; cB = nB; ++ui;
        if constexpr (ALIGN_EPI) { if (wr == 1) PG8_BAR; }
    }
    PG8_WAIT_V(0);
    if constexpr (!ALIGN_EPI) { if (wr == 0) PG8_BAR; }
    PG8_BAR;
    if constexpr (Epi::AFTER_DRAIN) { E.fused(acc, cur, wr, wc, fr, fq, lds, wid, lane); S.done(cur); }
#undef PG8_SA
#undef PG8_SB
#undef PG8_STAGE
#undef PG8_LDA
#undef PG8_LDB
#undef PG8_MMA
#undef PG8_WAIT_V
#undef PG8_WAIT_L
#undef PG8_BAR
#undef PG8_SCHED
}
}

namespace pg8 {
struct Unit2 { int pm, pn, kt0, nt; };
template <class Epi, class Sched, bool ROWPERM = false>
__device__ __forceinline__ void gemm_phase2(PG8_LAS unsigned char* lds, const Gemm g, const Sched& S, const Epi& E, const int wid) {
    int lane; asm volatile("v_mbcnt_lo_u32_b32 %0, -1, 0\n\tv_mbcnt_hi_u32_b32 %0, -1, %0" : "=v"(lane)); const int tid = wid * 64 + lane, wr = wid >> 2, wc = wid & 3, fr = lane & 15, fq = lane >> 4;
    const int K = g.K;
    unsigned voffA[2], voffB[2];
#pragma unroll
    for (int i = 0; i < 2; ++i) { int R, C; stage_rc(tid * 16 + i * 8192, R, C); const int Rb = Epi::PERM ? ((R & ~31) + perm32(R & 31)) : R;
        const int Ra = ROWPERM ? (128 * (R >> 6) + 8 * (R & 15) + ((R >> 4) & 3)) : R;
        voffA[i] = (unsigned)(Ra * K + C) * 2u; voffB[i] = (unsigned)(Rb * K + C) * 2u; }
    const size_t kstep = (size_t)(BK * 2);
    const size_t hstepB = (size_t)HALF * K * 2, hstepA = ROWPERM ? (size_t)4 * K * 2 : hstepB;
    const size_t tstep = (size_t)BM * K * 2;
    const unsigned ldsw = (unsigned)wid * 1024u;
    const int aoff = lds_byte(wr * 64 + fr, fq * 8), boff = lds_byte(wc * 32 + fr, fq * 8);
#define PG8_SA(b, h) (((b) * 2 + (h)) * HTB)
#define PG8_SB(b, h) ((4 + (b) * 2 + (h)) * HTB)
#define PG8_STAGE(bufoff, gbase, voff) do { _Pragma("unroll") for (int _i = 0; _i < 2; ++_i) \
        __builtin_amdgcn_global_load_lds((const unsigned*)((const char*)(gbase) + (voff)[_i]), (PG8_LAS unsigned*)(lds + (bufoff) + ldsw + _i * 8192), 16, 0, 0); } while (0)
#define PG8_LDA(dst, b, h) do { _Pragma("unroll") for (int m = 0; m < 4; ++m) _Pragma("unroll") for (int k = 0; k < 2; ++k) dst[m][k] = *(const PG8_LAS bf16x8*)(lds + PG8_SA(b, h) + aoff + m * 2048 + k * 1024); } while (0)
#define PG8_LDB(dst, b, h) do { _Pragma("unroll") for (int n = 0; n < 2; ++n) _Pragma("unroll") for (int k = 0; k < 2; ++k) dst[n][k] = *(const PG8_LAS bf16x8*)(lds + PG8_SB(b, h) + boff + n * 2048 + k * 1024); } while (0)
#define PG8_MMA(ai, bj, At, Bt) do { __builtin_amdgcn_s_setprio(1); _Pragma("unroll") for (int m = 0; m < 4; ++m) _Pragma("unroll") for (int n = 0; n < 2; ++n) _Pragma("unroll") for (int k = 0; k < 2; ++k) \
        acc[ai][bj][m][n] = __builtin_amdgcn_mfma_f32_16x16x32_bf16(Bt[n][k], At[m][k], acc[ai][bj][m][n], 0, 0, 0); __builtin_amdgcn_s_setprio(0); } while (0)
#define PG8_WAIT_V(n) asm volatile("s_waitcnt vmcnt(" #n ")" ::: "memory")
#define PG8_WAIT_L(n) asm volatile("s_waitcnt lgkmcnt(" #n ")" ::: "memory")
#define PG8_BAR __builtin_amdgcn_s_barrier()
#define PG8_SCHED __builtin_amdgcn_sched_barrier(0)
    Unit2 cur, nxt; int ui = 0;
    if (!S.next(0, cur)) return;
    f32x4 acc[2][2][4][2];
#pragma unroll
    for (int a = 0; a < 2; ++a)
#pragma unroll
        for (int b = 0; b < 2; ++b)
#pragma unroll
            for (int m = 0; m < 4; ++m)
#pragma unroll
                for (int n = 0; n < 2; ++n) acc[a][b][m][n] = (f32x4){0.f, 0.f, 0.f, 0.f};
    bf16x8 At[4][2], B0[2][2], B1[2][2];
    const char* cA = (const char*)g.A + (size_t)cur.pm * tstep + (size_t)cur.kt0 * kstep; const char* cB = (const char*)g.Bt + (size_t)cur.pn * tstep + (size_t)cur.kt0 * kstep;
    PG8_STAGE(PG8_SB(0, 0), cB, voffB); PG8_STAGE(PG8_SB(0, 1), cB + hstepB, voffB); PG8_STAGE(PG8_SA(0, 0), cA, voffA); PG8_STAGE(PG8_SA(0, 1), cA + hstepA, voffA);
    if (wr == 1) PG8_BAR;
    PG8_WAIT_V(2); PG8_BAR;
    PG8_STAGE(PG8_SB(1, 0), cB + kstep, voffB); PG8_STAGE(PG8_SA(1, 0), cA + kstep, voffA); PG8_STAGE(PG8_SB(1, 1), cB + hstepB + kstep, voffB);
    PG8_WAIT_V(6); PG8_BAR;
    for (;;) {
        const bool has_next = S.next(ui + 1, nxt);
        const char* nA = has_next ? (const char*)g.A + (size_t)nxt.pm * tstep + (size_t)nxt.kt0 * kstep : cA; const char* nB = has_next ? (const char*)g.Bt + (size_t)nxt.pn * tstep + (size_t)nxt.kt0 * kstep : cB;
        const int nt = cur.nt;
        for (int t = 0; t < nt; t += 2) {
            const bool last = (t == nt - 2);
            const char* a1 = cA + (size_t)(t + 1) * kstep;
            const char* a2 = last ? nA : cA + (size_t)(t + 2) * kstep; const char* b2 = last ? nB : cB + (size_t)(t + 2) * kstep;
            const char* a3 = a2 + kstep; const char* b3 = b2 + kstep;
            PG8_LDB(B0, 0, 0); PG8_LDB(B1, 0, 1); PG8_SCHED; PG8_LDA(At, 0, 0); PG8_STAGE(PG8_SA(1, 1), a1 + hstepA, voffA);
            PG8_WAIT_V(8); PG8_WAIT_L(0); PG8_BAR; PG8_MMA(0, 0, At, B0); PG8_MMA(0, 1, At, B1); PG8_BAR; PG8_SCHED;
            PG8_LDA(At, 0, 1); PG8_STAGE(PG8_SB(0, 0), b2, voffB); PG8_STAGE(PG8_SB(0, 1), b2 + hstepB, voffB); PG8_STAGE(PG8_SA(0, 0), a2, voffA);
            PG8_WAIT_V(8); PG8_WAIT_L(0); PG8_BAR; PG8_MMA(1, 0, At, B0); PG8_MMA(1, 1, At, B1); PG8_BAR; PG8_SCHED;
            PG8_LDB(B0, 1, 0); PG8_LDB(B1, 1, 1); PG8_SCHED; PG8_LDA(At, 1, 0); PG8_STAGE(PG8_SA(0, 1), a2 + hstepA, voffA);
            PG8_WAIT_V(8); PG8_WAIT_L(0); PG8_BAR; PG8_MMA(0, 0, At, B0); PG8_MMA(0, 1, At, B1); PG8_BAR; PG8_SCHED;
            PG8_LDA(At, 1, 1); PG8_STAGE(PG8_SB(1, 0), b3, voffB); PG8_STAGE(PG8_SB(1, 1), b3 + hstepB, voffB); PG8_STAGE(PG8_SA(1, 0), a3, voffA);
            PG8_WAIT_V(8); PG8_WAIT_L(0); PG8_BAR; PG8_MMA(1, 0, At, B0); PG8_MMA(1, 1, At, B1); PG8_BAR; PG8_SCHED;
        }
        if (wr == 0) PG8_BAR;
        E(acc, cur, wr, wc, fr, fq);
        if (!has_next) break;
#pragma unroll
        for (int a = 0; a < 2; ++a)
#pragma unroll
            for (int b = 0; b < 2; ++b)
#pragma unroll
                for (int m = 0; m < 4; ++m)
#pragma unroll
                    for (int n = 0; n < 2; ++n) acc[a][b][m][n] = (f32x4){0.f, 0.f, 0.f, 0.f};
        cur = nxt; cA = nA; cB = nB; ++ui;
        if (wr == 1) PG8_BAR;
    }
    PG8_WAIT_V(0);
    PG8_BAR;
#undef PG8_SA
#undef PG8_SB
#undef PG8_STAGE
#undef PG8_LDA
#undef PG8_LDB
#undef PG8_MMA
#undef PG8_WAIT_V
#undef PG8_WAIT_L
#undef PG8_BAR
#undef PG8_SCHED
}
}

namespace pg8 {
typedef float f32x4g __attribute__((ext_vector_type(4)));
template <class Epi, class Sched>
__device__ __forceinline__ void gemm_phase_cmpA(PG8_LAS unsigned char* lds, const float* cache_kv, const int* page_table, const bf16_t* Bt, const Sched& S, const Epi& E, const int wid) {
    int lane; asm volatile("v_mbcnt_lo_u32_b32 %0, -1, 0\n\tv_mbcnt_hi_u32_b32 %0, -1, %0" : "=v"(lane)); const int tid = wid * 64 + lane, wr = wid >> 2, wc = wid & 3, fr = lane & 15, fq = lane >> 4;
    constexpr int K = 1024;
    unsigned voffB[2];
#pragma unroll
    for (int i = 0; i < 2; ++i) { int R, C; stage_rc(tid * 16 + i * 8192, R, C); const int Rb = Epi::PERM ? ((R & ~31) + perm32(R & 31)) : R; voffB[i] = (unsigned)(Rb * K + C) * 2u; }
    const size_t kstepB = (size_t)(BK * 2), hstepB = (size_t)HALF * K * 2, tstepB = (size_t)BM * K * 2;
    const unsigned ldsw = (unsigned)wid * 1024u, ldst = (unsigned)tid * 16u;
    const int aoff = lds_byte(wr * 64 + fr, fq * 8), boff = lds_byte(wc * 32 + fr, fq * 8);
    const char* cbase = (const char*)cache_kv;
#define PG8_SA(b, h) (((b) * 2 + (h)) * HTB)
#define PG8_SB(b, h) ((4 + (b) * 2 + (h)) * HTB)
#define PG8_STAGE(bufoff, gbase, voff) do { _Pragma("unroll") for (int _i = 0; _i < 2; ++_i) \
        __builtin_amdgcn_global_load_lds((const unsigned*)((const char*)(gbase) + (voff)[_i]), (PG8_LAS unsigned*)(lds + (bufoff) + ldsw + _i * 8192), 16, 0, 0); } while (0)
#define PG8_ALOAD(r, off, h, kt) do { _Pragma("unroll") for (int _i = 0; _i < 2; ++_i) { const unsigned _o = (off)[h][_i] + (unsigned)(kt) * 4096u;        \
        asm volatile("s_nop 4\n\tglobal_load_dwordx4 %0, %2, %3\n\tglobal_load_dwordx4 %1, %2, %3 offset:16" : "=&v"(r[2 * _i]), "=&v"(r[2 * _i + 1]) : "v"(_o), "s"(cbase) : "memory"); } } while (0)
#define PG8_WAIT_VR(n, r) asm volatile("s_waitcnt vmcnt(" #n ")" : "+v"(r[0]), "+v"(r[1]), "+v"(r[2]), "+v"(r[3]) :: "memory")
#define PG8_AWRITE(r, bufoff) do { _Pragma("unroll") for (int _i = 0; _i < 2; ++_i) { u32x4 _w; _w.x = cvt_pk_bf16(r[2 * _i][0], r[2 * _i][1]); _w.y = cvt_pk_bf16(r[2 * _i][2], r[2 * _i][3]); \
        _w.z = cvt_pk_bf16(r[2 * _i + 1][0], r[2 * _i + 1][1]); _w.w = cvt_pk_bf16(r[2 * _i + 1][2], r[2 * _i + 1][3]); *(PG8_LAS u32x4*)(lds + (bufoff) + ldst + _i * 8192) = _w; } } while (0)
#define PG8_LDA(dst, b, h) do { _Pragma("unroll") for (int m = 0; m < 4; ++m) _Pragma("unroll") for (int k = 0; k < 2; ++k) dst[m][k] = *(const PG8_LAS bf16x8*)(lds + PG8_SA(b, h) + aoff + m * 2048 + k * 1024); } while (0)
#define PG8_LDB(dst, b, h) do { _Pragma("unroll") for (int n = 0; n < 2; ++n) _Pragma("unroll") for (int k = 0; k < 2; ++k) dst[n][k] = *(const PG8_LAS bf16x8*)(lds + PG8_SB(b, h) + boff + n * 2048 + k * 1024); } while (0)
#define PG8_MMA(ai, bj, At, Bt_) do { __builtin_amdgcn_s_setprio(1); _Pragma("unroll") for (int m = 0; m < 4; ++m) _Pragma("unroll") for (int n = 0; n < 2; ++n) _Pragma("unroll") for (int k = 0; k < 2; ++k) \
        acc[ai][bj][m][n] = __builtin_amdgcn_mfma_f32_16x16x32_bf16(Bt_[n][k], At[m][k], acc[ai][bj][m][n], 0, 0, 0); __builtin_amdgcn_s_setprio(0); } while (0)
#define PG8_WAIT_V(n) asm volatile("s_waitcnt vmcnt(" #n ")" ::: "memory")
#define PG8_WAIT_L(n) asm volatile("s_waitcnt lgkmcnt(" #n ")" ::: "memory")
#define PG8_BAR __builtin_amdgcn_s_barrier()
#define PG8_SCHED __builtin_amdgcn_sched_barrier(0)
#define PG8_AOFFS(off, u) do { const int _c = (u).pm / 264, _t = (u).pm % 264, _b = (_t >> 1) - 4, _g0 = 2 * (_t & 1); \
        int _ln; asm volatile("v_mbcnt_lo_u32_b32 %0, -1, 0\n\tv_mbcnt_hi_u32_b32 %0, -1, %0" : "=v"(_ln));        \
        _Pragma("unroll") for (int _i = 0; _i < 2; ++_i) { int _ra, _ca; stage_rc((wid * 64 + _ln) * 16 + _i * 8192, _ra, _ca); \
            const unsigned _base = ((unsigned)page_table[_b * 16 + (_ra >> 3)] * 128u + (unsigned)((_ra & 7) * 16)) * 4096u + (unsigned)(_c * 1024 + _g0 * 256 + _ca * 4); \
            (off)[0][_i] = _base; (off)[1][_i] = _base + 256u; } } while (0)
    Unit2 cur, nxt; int ui = 0;
    if (!S.next(0, cur)) return;
    f32x4 acc[2][2][4][2];
#pragma unroll
    for (int a = 0; a < 2; ++a)
#pragma unroll
        for (int b = 0; b < 2; ++b)
#pragma unroll
            for (int m = 0; m < 4; ++m)
#pragma unroll
                for (int n = 0; n < 2; ++n) acc[a][b][m][n] = (f32x4){0.f, 0.f, 0.f, 0.f};
    bf16x8 At[4][2], B0[2][2], B1[2][2];
    f32x4g RX[4], RY[4];
    unsigned cO[2][2], nO[2][2];
    PG8_AOFFS(cO, cur);
    const char* cB = (const char*)Bt + (size_t)cur.pn * tstepB;
    PG8_STAGE(PG8_SB(0, 0), cB, voffB); PG8_STAGE(PG8_SB(0, 1), cB + hstepB, voffB); PG8_ALOAD(RY, cO, 0, 0); PG8_ALOAD(RX, cO, 1, 0);
    if (wr == 1) PG8_BAR;
    PG8_WAIT_VR(4, RY); PG8_AWRITE(RY, PG8_SA(0, 0));
    PG8_STAGE(PG8_SB(1, 0), cB + kstepB, voffB); PG8_STAGE(PG8_SB(1, 1), cB + hstepB + kstepB, voffB); PG8_ALOAD(RY, cO, 0, 1);
    PG8_WAIT_L(0); PG8_BAR;
    for (;;) {
        const bool has_next = S.next(ui + 1, nxt);
        if (has_next) PG8_AOFFS(nO, nxt); else { _Pragma("unroll") for (int _h = 0; _h < 2; ++_h) _Pragma("unroll") for (int _i = 0; _i < 2; ++_i) nO[_h][_i] = cO[_h][_i]; }
        const char* nB = has_next ? (const char*)Bt + (size_t)nxt.pn * tstepB : cB;
        const int nt = K / BK;
        for (int t = 0; t < nt; t += 2) {
            const bool last = (t == nt - 2);
            const char* b2 = last ? nB : cB + (size_t)(t + 2) * kstepB; const char* b3 = b2 + kstepB;
            PG8_LDB(B0, 0, 0); PG8_LDB(B1, 0, 1); PG8_SCHED; PG8_LDA(At, 0, 0);
            PG8_WAIT_VR(8, RX); PG8_AWRITE(RX, PG8_SA(0, 1)); PG8_ALOAD(RX, cO, 1, t + 1);
            PG8_WAIT_L(0); PG8_BAR; PG8_MMA(0, 0, At, B0); PG8_MMA(0, 1, At, B1); PG8_BAR; PG8_SCHED;
            PG8_LDA(At, 0, 1); PG8_STAGE(PG8_SB(0, 0), b2, voffB); PG8_STAGE(PG8_SB(0, 1), b2 + hstepB, voffB);
            PG8_WAIT_VR(8, RY); PG8_AWRITE(RY, PG8_SA(1, 0)); if (last) PG8_ALOAD(RY, nO, 0, 0); else PG8_ALOAD(RY, cO, 0, t + 2);
            PG8_WAIT_L(0); PG8_BAR; PG8_MMA(1, 0, At, B0); PG8_MMA(1, 1, At, B1); PG8_BAR; PG8_SCHED;
            PG8_LDB(B0, 1, 0); PG8_LDB(B1, 1, 1); PG8_SCHED; PG8_LDA(At, 1, 0);
            PG8_WAIT_VR(8, RX); PG8_AWRITE(RX, PG8_SA(1, 1)); if (last) PG8_ALOAD(RX, nO, 1, 0); else PG8_ALOAD(RX, cO, 1, t + 2);
            PG8_WAIT_L(0); PG8_BAR; PG8_MMA(0, 0, At, B0); PG8_MMA(0, 1, At, B1); PG8_BAR; PG8_SCHED;
            PG8_LDA(At, 1, 1); PG8_STAGE(PG8_SB(1, 0), b3, voffB); PG8_STAGE(PG8_SB(1, 1), b3 + hstepB, voffB);
            PG8_WAIT_VR(8, RY); PG8_AWRITE(RY, PG8_SA(0, 0)); if (last) PG8_ALOAD(RY, nO, 0, 1); else PG8_ALOAD(RY, cO, 0, t + 3);
            PG8_WAIT_L(0); PG8_BAR; PG8_MMA(1, 0, At, B0); PG8_MMA(1, 1, At, B1); PG8_BAR; PG8_SCHED;
        }
        if (wr == 0) PG8_BAR;
        E(acc, cur, wr, wc, fr, fq);
        if (!has_next) break;
#pragma unroll
        for (int a = 0; a < 2; ++a)
#pragma unroll
            for (int b = 0; b < 2; ++b)
#pragma unroll
                for (int m = 0; m < 4; ++m)
#pragma unroll
                    for (int n = 0; n < 2; ++n) acc[a][b][m][n] = (f32x4){0.f, 0.f, 0.f, 0.f};
        cur = nxt; cB = nB; ++ui;
#pragma unroll
        for (int _h = 0; _h < 2; ++_h)
#pragma unroll
            for (int _i = 0; _i < 2; ++_i) cO[_h][_i] = nO[_h][_i];
        if (wr == 1) PG8_BAR;
    }
    asm volatile("s_waitcnt vmcnt(0)" : "+v"(RX[0]), "+v"(RX[1]), "+v"(RX[2]), "+v"(RX[3]), "+v"(RY[0]), "+v"(RY[1]), "+v"(RY[2]), "+v"(RY[3]) :: "memory");
    PG8_BAR;
#undef PG8_SA
#undef PG8_SB
#undef PG8_STAGE
#undef PG8_ALOAD
#undef PG8_WAIT_VR
#undef PG8_AWRITE
#undef PG8_LDA
#undef PG8_LDB
#undef PG8_MMA
#undef PG8_WAIT_V
#undef PG8_WAIT_L
#undef PG8_BAR
#undef PG8_SCHED
#undef PG8_AOFFS
}
}
#define XB_TMO      128
#define XB_XCNT(j)  (256  + 64 * (j))
#define XB_XSUB(j)  (1280 + 64 * (j))
#define XB_XGEN(j)  (2304 + 64 * (j))
#define XB_TOP      3328
#define XB_TOPGEN   3392
#define XCD_BAR_WORDS 3456
#define XB_SPIN_CAP (1u << 18)
#define LAS __attribute__((address_space(3)))

__device__ __forceinline__ unsigned xb_ld(unsigned* p)              { return __hip_atomic_load(p, __ATOMIC_RELAXED, __HIP_MEMORY_SCOPE_AGENT); }
__device__ __forceinline__ unsigned xb_add(unsigned* p, unsigned v) { return __hip_atomic_fetch_add(p, v, __ATOMIC_RELAXED, __HIP_MEMORY_SCOPE_AGENT); }
__device__ __forceinline__ unsigned xb_xcc_id() { return (unsigned)__builtin_amdgcn_s_getreg((3 << 11) | 20) & 0xFu; }
#define XB_SPIN(cond, bar) do { unsigned _sp = 0; while (cond) { __builtin_amdgcn_s_sleep(1); \
    if ((++_sp & 255u) == 0u) { if (xb_ld(&(bar)[XB_TMO])) break; if (_sp > XB_SPIN_CAP) { atomicAdd(&(bar)[XB_TMO], 1u); break; } } } } while (0)

__device__ __forceinline__ int xb_lane() { int l; asm volatile("v_mbcnt_lo_u32_b32 %0, -1, 0\n\tv_mbcnt_hi_u32_b32 %0, -1, %0" : "=v"(l)); return l; }
struct XcdBarrier {
    int wave; unsigned* bar; unsigned x;
    volatile LAS unsigned* st;
};

__device__ __forceinline__ XcdBarrier xcd_barrier_post(unsigned* bar, volatile LAS unsigned* st, int wave) {
    XcdBarrier b; b.wave = wave; b.bar = bar; b.x = xb_xcc_id(); b.st = st;
    if (wave == 0 && xb_lane() == 0) (void)xb_add(&bar[XB_XCNT(b.x)], 1u);
    return b;
}
__device__ __forceinline__ void xcd_barrier_complete(unsigned* bar, unsigned x, unsigned& nloc, unsigned& nx) {
    const unsigned G = gridDim.x * gridDim.y * gridDim.z;
    unsigned sum, cnt, mine, sp = 0u;
    for (;;) {
        sum = 0u; cnt = 0u; mine = 0u;
#pragma unroll
        for (unsigned j = 0; j < 16; ++j) { const unsigned c = xb_ld(&bar[XB_XCNT(j)]); sum += c; cnt += (c > 0u) ? 1u : 0u; mine = (j == x) ? c : mine; }
        if (sum == G) break;
        __builtin_amdgcn_s_sleep(1);
        if ((++sp & 255u) == 0u) { if (xb_ld(&bar[XB_TMO])) break; if (sp > XB_SPIN_CAP) { atomicAdd(&bar[XB_TMO], 1u); break; } }
    }
    nloc = mine > 0u ? mine : 1u; nx = cnt > 0u ? cnt : 1u;
}

__device__ __forceinline__ void xcd_barrier(const XcdBarrier& b) {
    asm volatile("s_waitcnt vmcnt(0)" ::: "memory");
    __syncthreads();
    if (b.wave == 0 && xb_lane() == 0) {
        unsigned* bar = b.bar;
        __builtin_amdgcn_s_waitcnt(0);
        unsigned nloc = b.st[0], nx = b.st[1];
        if (nloc == 0u) { xcd_barrier_complete(bar, b.x, nloc, nx); b.st[0] = nloc; b.st[1] = nx; }
        const unsigned old = xb_add(&bar[XB_XSUB(b.x)], 1u);
        const unsigned gen = old / nloc;
        if (old + 1u == (gen + 1u) * nloc) {
            __builtin_amdgcn_fence(__ATOMIC_RELEASE, "agent");
            asm volatile("s_waitcnt vmcnt(0)" ::: "memory");
            const unsigned og = xb_add(&bar[XB_TOP], 1u);
            const unsigned tg = og / nx;
            if (og + 1u == (tg + 1u) * nx) xb_add(&bar[XB_TOPGEN], 1u);
            else XB_SPIN(xb_ld(&bar[XB_TOPGEN]) == tg, bar);
            __builtin_amdgcn_fence(__ATOMIC_ACQUIRE, "agent");
            xb_add(&bar[XB_XGEN(b.x)], 1u);
            asm volatile("s_waitcnt vmcnt(0)" ::: "memory");
        } else {
            XB_SPIN(xb_ld(&bar[XB_XGEN(b.x)]) == gen, bar);
            __builtin_amdgcn_fence(__ATOMIC_ACQUIRE, "agent");
            asm volatile("s_waitcnt vmcnt(0)" ::: "memory");
        }
    }
    __syncthreads();
}

#ifndef MK_DUPF
#define MK_DUPF -1
#endif
namespace mk {
#define DI __device__ __forceinline__
typedef unsigned short bf16_t;
typedef float f32x4 __attribute__((ext_vector_type(4)));
typedef unsigned u32x4 __attribute__((ext_vector_type(4)));
typedef unsigned u32x2 __attribute__((ext_vector_type(2)));

constexpr int D = 2048, NP = 8192, NS = 1024, MT = 9216, TP = 2048, DIN = 6704, DINP = 6912, FF = 5632, FF2 = 11264;
constexpr int NBB = 132;
constexpr int CM = NBB * 4 * 128;
constexpr float EPS = 1e-6f;
constexpr int Z_RQ = 0, Z_RK = 1024, Z_RV = 2048, Z_RG = 3072, Z_NQ = 4096, Z_NKV = 5120, Z_NG = 6656;
constexpr size_t O_Y = 0, O_KV = O_Y + (size_t)MT * D, O_WINP = O_KV + (size_t)MT * 1024, O_WINS = O_WINP + (size_t)4 * 512 * 512,
                 O_RETP = O_WINS + (size_t)128 * 512 * 512, O_RETS = O_RETP + (size_t)16 * 65536, O_CONVP = O_RETS + (size_t)512 * 65536,
                 O_CONVS = O_CONVP + (size_t)4 * 2 * FF2, O_END = O_CONVS + (size_t)128 * 2 * FF2;
constexpr size_t al256(size_t x) { return (x + 255) & ~(size_t)255; }
constexpr size_t WS_CTL = 0, CTL_BYTES = 1u << 20;
constexpr size_t CTL_BAR = 16384;
constexpr size_t CTL_ROWSS = 65536;
constexpr size_t CTL_PAIR = 262144;
constexpr size_t CTL_PEB = 131072;
constexpr size_t WS_W1T = CTL_BYTES;
constexpr size_t WS_W2T = al256(WS_W1T + (size_t)DINP * D * 2);
constexpr size_t WS_W3T = al256(WS_W2T + (size_t)D * D * 2);
constexpr size_t WS_W4T = al256(WS_W3T + (size_t)FF2 * D * 2);
constexpr size_t WS_WC1T = al256(WS_W4T + (size_t)D * FF * 2);
constexpr size_t WS_XG = al256(WS_WC1T + (size_t)1024 * 1024 * 2);
constexpr size_t WS_RSTD1 = al256(WS_XG + (size_t)MT * D * 2);
constexpr size_t WS_SINCOS = al256(WS_RSTD1 + (size_t)MT * 4);
constexpr size_t WS_Z = al256(WS_SINCOS + (size_t)2056 * 128 * 8);
constexpr size_t WS_RQ = al256(WS_Z + (size_t)MT * DINP * 4);
constexpr size_t WS_RK = al256(WS_RQ + (size_t)MT * 1024 * 2);
constexpr size_t WS_RV = al256(WS_RK + (size_t)MT * 1024 * 2);
constexpr size_t WS_NQ = al256(WS_RV + (size_t)MT * 1024 * 2);
constexpr size_t WS_KSLC = al256(WS_NQ + (size_t)MT * 1024 * 2);
constexpr size_t WS_VSLC = al256(WS_KSLC + (size_t)MT * 256 * 2);
constexpr size_t WS_KWIN = al256(WS_VSLC + (size_t)MT * 256 * 2);
constexpr size_t WS_VWIN = al256(WS_KWIN + (size_t)MT * 256 * 2);
constexpr size_t WS_GATES = al256(WS_VWIN + (size_t)MT * 256 * 2);
constexpr size_t WS_CBU = al256(WS_GATES + (size_t)MT * 48 * 4);
constexpr size_t WS_HPRE = al256(WS_CBU + (size_t)2 * CM * 1024 * 2);
constexpr size_t WS_KC = al256(WS_HPRE + (size_t)2 * CM * 512 * 2);
constexpr size_t WS_VC = al256(WS_KC + (size_t)NBB * 4 * 128 * 64 * 2);
constexpr size_t WS_KVC = al256(WS_VC + (size_t)NBB * 4 * 128 * 64 * 2);
constexpr size_t WS_SST = al256(WS_KVC + (size_t)256 * 65536 * 4);
constexpr size_t WS_MIX = al256(WS_SST + (size_t)256 * 65536 * 4);
constexpr size_t WS_H = al256(WS_MIX + (size_t)MT * 2048 * 2);
constexpr size_t WS_HG = al256(WS_H + (size_t)MT * D * 4);
constexpr size_t WS_U = al256(WS_HG + (size_t)MT * D * 2);
constexpr size_t WS_ACT = al256(WS_U + (size_t)MT * FF2 * 2);
constexpr size_t WS_KSP = al256(WS_ACT + (size_t)MT * FF * 2);
constexpr size_t WS_VSPT = al256(WS_KSP + (size_t)16 * 2048 * 64 * 2);
constexpr size_t WS_KWP = al256(WS_VSPT + (size_t)16 * 2048 * 64 * 2);
constexpr size_t WS_VWPT = al256(WS_KWP + (size_t)16 * 2048 * 64 * 2);
constexpr size_t WS_VCT = al256(WS_VWPT + (size_t)16 * 2048 * 64 * 2);
constexpr size_t WS_RGS = al256(WS_VCT + (size_t)NBB * 4 * 64 * 128 * 2);
constexpr size_t WS_NORMS = al256(WS_RGS + (size_t)MT * 1024 * 2);
constexpr size_t WS_SLAB = al256(WS_NORMS + 3 * 64 * 4);
constexpr size_t WS_UX = al256(WS_SLAB + (size_t)8 * NS * D * 4);
constexpr size_t WS_RKT = al256(WS_UX + (size_t)32 * 8 * FF2 * 4);
constexpr size_t WS_RVT = al256(WS_RKT + (size_t)16 * 256 * 2048 * 2);
constexpr size_t WS_KVT = al256(WS_RVT + (size_t)16 * 256 * 2048 * 2);
constexpr size_t WS_SSTT = al256(WS_KVT + (size_t)256 * 65536 * 4);
constexpr size_t WS_END = al256(WS_SSTT + (size_t)256 * 65536 * 2);
static_assert(WS_VSLC - WS_KSLC == (size_t)MT * 512 && WS_KWIN - WS_VSLC == (size_t)MT * 512 && WS_VWIN - WS_KWIN == (size_t)MT * 512, "token-major k/v buffers equally spaced");
static_assert(WS_VSPT - WS_KSP == 4194304 && WS_KWP - WS_VSPT == 4194304 && WS_VWPT - WS_KWP == 4194304, "per-sequence k/v buffers equally spaced");

constexpr int LDS_BYTES = 163840;
constexpr int LDS_MISC = LDS_BYTES - 256;

struct P {
    const float *x_prompt, *x_sample, *cache_kv, *cache_win, *state_ret, *state_conv; const int* page_table;
    const float *g_attn, *w_in, *q_norm, *k_norm_cmp, *k_norm_slc, *k_norm_win, *cmp_pe, *cmp_w1, *cmp_b1, *cmp_w2, *cmp_b2, *ret_gn, *w_out, *g_ffn, *w_up, *conv_w, *conv_b, *w_down;
    float* out; unsigned char* ws; int lo, hi;
};

DI int mk_tid(int wave) { int lane; asm volatile("v_mbcnt_lo_u32_b32 %0, -1, 0\n\tv_mbcnt_hi_u32_b32 %0, -1, %0" : "=v"(lane)); return wave * 64 + lane; }
DI float bf2f(bf16_t b) { return __uint_as_float(((unsigned)b) << 16); }
DI unsigned f2bf(float f) { unsigned u = __float_as_uint(f); return (u + 0x7fffu + ((u >> 16) & 1u)) >> 16; }
DI unsigned pk2(float lo, float hi) { return f2bf(lo) | (f2bf(hi) << 16); }
DI float wave_sum(float v) {
#pragma unroll
    for (int o = 1; o < 64; o <<= 1) v += __shfl_xor(v, o);
    return v; }
DI float wave_max(float v) {
#pragma unroll
    for (int o = 1; o < 64; o <<= 1) v = fmaxf(v, __shfl_xor(v, o));
    return v; }
DI float silu_f(float x) { return x / (1.f + __expf(-x)); }
DI float sigmoid_f(float x) { return 1.f / (1.f + __expf(-x)); }
DI const float* xrow(const P& p, int m) { return m < NP ? p.x_prompt + (size_t)m * D : p.x_sample + (size_t)(m - NP) * D; }
#define LDS_WAIT() asm volatile("s_waitcnt lgkmcnt(0)" ::: "memory")

DI void transpose_item(const float* W, int N, bf16_t* WT, int K, LAS float* scr, int k0, int n0, int lane, int nsrc0 = -1) {
    const int nn = (nsrc0 < 0 ? n0 : nsrc0) + (lane & 31);
    float v[32];
#pragma unroll
    for (int i = 0; i < 32; ++i) { const int kk = 2 * i + (lane >> 5); v[i] = nn < N ? W[(size_t)(k0 + kk) * N + nn] : 0.f; }
#pragma unroll
    for (int i = 0; i < 32; ++i) { const int kk = 2 * i + (lane >> 5); scr[kk * 33 + (lane & 31)] = v[i]; }
    LDS_WAIT();
    const int c = lane & 7;
#pragma unroll
    for (int j = 0; j < 4; ++j) { const int n = (lane >> 3) + 8 * j; const LAS float* s = scr + (8 * c) * 33 + n;
        u32x4 o; o.x = pk2(s[0 * 33], s[1 * 33]); o.y = pk2(s[2 * 33], s[3 * 33]); o.z = pk2(s[4 * 33], s[5 * 33]); o.w = pk2(s[6 * 33], s[7 * 33]);
        *(u32x4*)(WT + (size_t)(n0 + n) * K + k0 + 8 * c) = o; }
    LDS_WAIT();
}


constexpr int CB_P0 = 2048;
DI void phase_cb_convert(const P& p, int bid, int G, int it0, int it1) {
    int tid = mk_tid(p.hi); unsigned char* ws = p.ws;
    {
        bf16_t* CBU = (bf16_t*)(ws + WS_CBU);
        for (int it = it0 + bid; it < it1; it += G) {
            const int b = it >> 4, pi = it & 15, page = p.page_table[b * 16 + pi];
            const float* src = p.cache_kv + (size_t)page * 128 * 1024;
#pragma unroll 1
            for (int q0 = tid; q0 < 128 * 2 * 64; q0 += 512 * 16) {
                f32x4 v[16];
#pragma unroll
                for (int e = 0; e < 16; ++e) { const int q = q0 + 512 * e, r = q >> 7, c = (q >> 6) & 1, f = q & 63; v[e] = *(const f32x4*)(src + (size_t)r * 1024 + c * 256 + f * 4); }
#pragma unroll
                for (int e = 0; e < 16; ++e) { const int q = q0 + 512 * e, r = q >> 7, c = (q >> 6) & 1, f = q & 63, g = f >> 4, d = (f & 15) * 4;
                    u32x2 w; w.x = pk2(v[e].x, v[e].y); w.y = pk2(v[e].z, v[e].w);
                    *(u32x2*)(CBU + ((((size_t)c * NBB + 4 + b) * 4 + g) * 2048 + pi * 128 + r) * 64 + d) = w; }
            }
        }
    }
}
DI void phase_win_copy(const P& p, int bid, int G) {
    int tid = mk_tid(p.hi);
    {
        float* WS_ = p.out + O_WINS;
#pragma unroll 1
        for (int it = bid; it < 128 * 6; it += G) {
            const size_t b = it / 6; const int g0 = (it % 6) * 21; f32x4 v[21];
#pragma unroll
            for (int e = 0; e < 21; ++e) v[e] = __builtin_nontemporal_load((const f32x4*)(p.cache_win + b * 512 * 512 + 8 * 512 + ((size_t)(g0 + e) * 512 + tid) * 4));
#pragma unroll
            for (int e = 0; e < 21; ++e) __builtin_nontemporal_store(v[e], (f32x4*)(WS_ + b * 512 * 512 + ((size_t)(g0 + e) * 512 + tid) * 4));
        }
    }
}

DI void phase_prologue(const P& p, LAS unsigned char* lds, int bid, int G) {
    int tid = mk_tid(p.hi); const int lane = tid & 63, wave = tid >> 6;
    const int gw = bid * 8 + wave, NGW = G * 8;
    unsigned char* ws = p.ws;
    for (int rep = 0; rep < (MK_DUPF == 1 ? 2 : 1); ++rep) {
        LAS float* scr = (LAS float*)(lds + wave * 16384);
        for (int r = gw; r < 32 * 216; r += NGW) { const int n0 = (r % 216) * 32, pn = n0 >> 8; int ns = n0;
            if (pn >= 16 && pn < 26) { const int q = n0 & 255; ns = (n0 & ~255) + 64 * ((q >> 5) & 3) + 32 * (q >> 7); }
            transpose_item(p.w_in, DIN, (bf16_t*)(ws + WS_W1T), D, scr, (r / 216) * 64, n0, lane, ns); }
        for (int r = gw - (NGW >= 1536 ? 1024 : 0); r >= 0 && r < 4 * 128; r += NGW) { const int cj = r / 128, q = r % 128;
            transpose_item(p.cmp_w1 + (size_t)cj * 1024 * 256, 256, (bf16_t*)(ws + WS_WC1T) + (size_t)cj * 256 * 1024, 1024, scr, (q / 8) * 64, (q % 8) * 32, lane); }
    }
    for (int rep = 0; rep < (MK_DUPF == 2 ? 2 : 1); ++rep) {
        bf16_t* XG = (bf16_t*)(ws + WS_XG); float* RSTD = (float*)(ws + WS_RSTD1);
        for (int m = gw; m < MT; m += NGW) {
            const f32x4* xr = (const f32x4*)xrow(p, m) + lane; const f32x4* gr = (const f32x4*)p.g_attn + lane;
            f32x4 v[8]; float s = 0.f;
#pragma unroll
            for (int j = 0; j < 8; ++j) { v[j] = xr[64 * j]; s += (v[j].x * v[j].x + v[j].y * v[j].y) + (v[j].z * v[j].z + v[j].w * v[j].w); }
            s = wave_sum(s);
            if (lane == 0) RSTD[m] = rsqrtf(s * (1.f / D) + EPS);
            u32x2* o = (u32x2*)(XG + (size_t)m * D) + lane;
#pragma unroll
            for (int j = 0; j < 8; ++j) { const f32x4 g = gr[64 * j]; u32x2 w; w.x = pk2(v[j].x * g.x, v[j].y * g.y); w.y = pk2(v[j].z * g.z, v[j].w * g.w); o[64 * j] = w; }
        }
    }
    {
        float2* SC = (float2*)(ws + WS_SINCOS);
        for (int i = bid * 512 + tid; i < 2056 * 128; i += G * 512) {
            const int pos = i >> 7, k = i & 127;
            const double inv = exp(-(double)k * (9.210340371976184 / 127.0));
            double rev = (double)pos * inv * 0.15915494309189535; rev -= floor(rev);
            const float rf = (float)rev;
            SC[i] = make_float2(__builtin_amdgcn_cosf(rf), __builtin_amdgcn_sinf(rf));
        }
    }
    if (bid == 0 && tid < 192) ((float*)(ws + WS_NORMS))[tid] = tid < 64 ? p.q_norm[tid] : (tid < 128 ? p.k_norm_slc[tid - 64] : p.k_norm_win[tid - 128]);
    if (bid < 32) {
        const int c = bid >> 4, k0 = (bid & 15) * 128, h = tid & 255, half = tid >> 8;
        float s = 0.f;
        for (int k = k0 + half * 64; k < k0 + half * 64 + 64; ++k) s += p.cmp_pe[c * 2048 + k] * p.cmp_w1[((size_t)c * 2048 + k) * 256 + h];
        atomicAdd((float*)(ws + CTL_PEB) + c * 256 + h, s);
    }
}


constexpr int I1 = 32 * 64, I2 = 32 * 352, I3 = 88 * 64;
DI void slice_one(const P& p, LAS float* scr, int r, int lane) {
    unsigned char* ws = p.ws;
    if (r < I1) { transpose_item(p.w_out, D, (bf16_t*)(ws + WS_W2T), D, scr, (r / 64) * 64, (r % 64) * 32, lane); return; } r -= I1;
    if (r < I2) { const int n0 = (r % 352) * 32; transpose_item(p.w_up, FF2, (bf16_t*)(ws + WS_W3T), D, scr, (r / 352) * 64, n0, lane, ((n0 >> 7) & 1) * FF + 128 * (n0 >> 8) + (n0 & 127)); return; } r -= I2;
    transpose_item(p.w_down, D, (bf16_t*)(ws + WS_W4T), FF, scr, (r / 64) * 64, (r % 64) * 32, lane);
}
DI void phase_slice(const P& p, LAS unsigned char* lds, int bid, int G, int it0, int it1) {
    int tid = mk_tid(p.hi);
    const int lane = tid & 63, wave = __builtin_amdgcn_readfirstlane(tid >> 6); const int gw = bid * 8 + wave, NGW = G * 8; unsigned char* ws = p.ws;
    LAS float* scr = (LAS float*)(lds + wave * 16384);
    for (int it = it0 + gw; it < it1; it += NGW) slice_one(p, scr, it, lane);
}
DI void phase_post(const P& p, LAS unsigned char* lds, int bid, int G) {
    int tid = mk_tid(p.hi); const int lane = tid & 63, wave = tid >> 6;
    unsigned char* ws = p.ws;
    const float* Z = (const float*)(ws + WS_Z); const float2* SC = (const float2*)(ws + WS_SINCOS);
    bf16_t *RQ = (bf16_t*)(ws + WS_RQ), *RK = (bf16_t*)(ws + WS_RK), *RV = (bf16_t*)(ws + WS_RV), *NQ = (bf16_t*)(ws + WS_NQ);
    bf16_t *KSLC = (bf16_t*)(ws + WS_KSLC), *VSLC = (bf16_t*)(ws + WS_VSLC), *KWIN = (bf16_t*)(ws + WS_KWIN), *VWIN = (bf16_t*)(ws + WS_VWIN), *CBU = (bf16_t*)(ws + WS_CBU);
    float* GATES = (float*)(ws + WS_GATES);
    bf16_t *KSP = (bf16_t*)(ws + WS_KSP), *VSPT = (bf16_t*)(ws + WS_VSPT), *KWP = (bf16_t*)(ws + WS_KWP), *VWPT = (bf16_t*)(ws + WS_VWPT);
    for (int m = bid; m < MT; m += G) {
        const float* zr = Z + (size_t)m * DINP;
        const bool prompt = m < NP; const int b = prompt ? (m >> 11) : ((m - NP) >> 3), t = prompt ? (m & 2047) : ((m - NP) & 7), pos = prompt ? t : 2048 + t;
        { const int hh = tid >> 7, ii = tid & 127; const float2 cs = SC[pos * 128 + ii];
#pragma unroll
          for (int w = 0; w < 2; ++w) { const float x1 = zr[w * 1024 + hh * 256 + ii], x2 = zr[w * 1024 + hh * 256 + 128 + ii]; const float sc = w ? 0.0625f : 1.f;
              bf16_t* dst = (w ? RK : RQ) + (size_t)m * 1024 + hh * 256 + ii;
              dst[0] = (bf16_t)f2bf((x1 * cs.x - x2 * cs.y) * sc); dst[128] = (bf16_t)f2bf((x2 * cs.x + x1 * cs.y) * sc); } }
        RV[(size_t)m * 1024 + tid] = (bf16_t)f2bf(zr[Z_RV + tid]); RV[(size_t)m * 1024 + 512 + tid] = (bf16_t)f2bf(zr[Z_RV + 512 + tid]);
#pragma unroll
        for (int q = 0; q < 2; ++q) { const int hd = 2 * wave + q; const float v = zr[Z_NQ + hd * 64 + lane]; const float r = rsqrtf(wave_sum(v * v) * (1.f / 64.f) + EPS);
            NQ[(size_t)m * 1024 + hd * 64 + lane] = (bf16_t)f2bf(v * r * p.q_norm[lane] * 0.125f); }
#pragma unroll
        for (int q = 0; q < 3; ++q) { const int vi = wave + 8 * q, s = vi >> 2, g = vi & 3; float v = zr[Z_NKV + vi * 64 + lane];
            if (s == 2 || s == 4) { const float r = rsqrtf(wave_sum(v * v) * (1.f / 64.f) + EPS); v = v * r * (s == 2 ? p.k_norm_slc[lane] : p.k_norm_win[lane]); }
            if (s < 4) { p.out[O_KV + (size_t)m * 1024 + s * 256 + g * 64 + lane] = v;
                if (s < 2) { if (prompt) CBU[((((size_t)s * NBB + b) * 4 + g) * 2048 + t) * 64 + lane] = (bf16_t)f2bf(v); }
                else { (s == 2 ? KSLC : VSLC)[(size_t)m * 256 + g * 64 + lane] = (bf16_t)f2bf(v);
                    if (prompt) { if (s == 2) KSP[(((size_t)b * 4 + g) * 2048 + t) * 64 + lane] = (bf16_t)f2bf(v); else VSPT[(((size_t)b * 4 + g) * 64 + lane) * 2048 + t] = (bf16_t)f2bf(v); } }
            } else { (s == 4 ? KWIN : VWIN)[(size_t)m * 256 + g * 64 + lane] = (bf16_t)f2bf(v);
                if (prompt) { if (s == 4) KWP[(((size_t)b * 4 + g) * 2048 + t) * 64 + lane] = (bf16_t)f2bf(v); else VWPT[(((size_t)b * 4 + g) * 64 + lane) * 2048 + t] = (bf16_t)f2bf(v); }
                if (prompt) { if (t >= 1536) p.out[O_WINP + (((size_t)b * 512 + (t - 1536)) * 2 + (s - 4)) * 256 + g * 64 + lane] = v; }
                else p.out[O_WINS + (((size_t)b * 512 + 504 + t) * 2 + (s - 4)) * 256 + g * 64 + lane] = v; } }
        if (tid < 48) GATES[(size_t)m * 48 + tid] = sigmoid_f(zr[Z_NG + tid]);
    }
}


DI void load8(const bf16_t* p, float (&v)[8]) { const u32x4 r = *(const u32x4*)p; v[0] = __uint_as_float(r.x << 16); v[1] = __uint_as_float(r.x & 0xffff0000u); v[2] = __uint_as_float(r.y << 16); v[3] = __uint_as_float(r.y & 0xffff0000u);
    v[4] = __uint_as_float(r.z << 16); v[5] = __uint_as_float(r.z & 0xffff0000u); v[6] = __uint_as_float(r.w << 16); v[7] = __uint_as_float(r.w & 0xffff0000u); }
DI void load8(const float* p, float (&v)[8]) { const f32x4 a = *(const f32x4*)p, b = *(const f32x4*)(p + 4); v[0] = a.x; v[1] = a.y; v[2] = a.z; v[3] = a.w; v[4] = b.x; v[5] = b.y; v[6] = b.z; v[7] = b.w; }
DI float gamma_log2(int h) { return log2f(1.f - exp2f(-5.f - (float)h)); }

DI void phase_ret_kv(const P& p, LAS unsigned char* lds, int bid, int G) {
    int tid = mk_tid(p.hi); unsigned char* ws = p.ws;
    const bf16_t *RK = (const bf16_t*)(ws + WS_RK), *RV = (const bf16_t*)(ws + WS_RV); float* KVC = (float*)(ws + WS_KVC);
    LAS float* ks = (LAS float*)lds; LAS float* vs = ks + 32 * 256;
    const int ty = tid >> 5, tx = tid & 31;
    for (int unit = bid; unit < 256; unit += G) {
        const int b = unit >> 6, h = (unit >> 4) & 3, c = unit & 15; const float lg = gamma_log2(h);
        float acc[16][8];
#pragma unroll
        for (int a = 0; a < 16; ++a)
#pragma unroll
            for (int e = 0; e < 8; ++e) acc[a][e] = 0.f;
        for (int jc = 0; jc < 4; ++jc) {
            __syncthreads();
#pragma unroll 4
            for (int i = 0; i < 16; ++i) { const int idx = tid + 512 * i, j = idx >> 8, dc = idx & 255; const size_t m = (size_t)b * 2048 + c * 128 + jc * 32 + j;
                ks[idx] = bf2f(RK[m * 1024 + h * 256 + dc]) * exp2f(lg * (float)(127 - (jc * 32 + j))); vs[idx] = bf2f(RV[m * 1024 + h * 256 + dc]); }
            __syncthreads();
            for (int j = 0; j < 32; ++j) {
                f32x4 kr[4], vr[2];
#pragma unroll
                for (int q = 0; q < 4; ++q) kr[q] = *(const LAS f32x4*)(ks + j * 256 + ty * 16 + q * 4);
#pragma unroll
                for (int q = 0; q < 2; ++q) vr[q] = *(const LAS f32x4*)(vs + j * 256 + tx * 8 + q * 4);
#pragma unroll
                for (int a = 0; a < 16; ++a)
#pragma unroll
                    for (int e = 0; e < 8; ++e) acc[a][e] += kr[a >> 2][a & 3] * vr[e >> 2][e & 3];
            }
        }
        float* o = KVC + (size_t)unit * 65536;
#pragma unroll
        for (int a = 0; a < 16; ++a) { *(f32x4*)(o + (ty * 16 + a) * 256 + tx * 8) = (f32x4){acc[a][0], acc[a][1], acc[a][2], acc[a][3]}; *(f32x4*)(o + (ty * 16 + a) * 256 + tx * 8 + 4) = (f32x4){acc[a][4], acc[a][5], acc[a][6], acc[a][7]}; }
    }
}

DI void phase_ret_scan(const P& p, int bid, int G) {
    int tid = mk_tid(p.hi); unsigned char* ws = p.ws;
    const float* KVC = (const float*)(ws + WS_KVC); float* SST = (float*)(ws + WS_SST);
    for (int i = bid * 512 + tid; i < 16 * 16384; i += G * 512) {
        const int bh = i >> 14, e = (i & 16383) * 4; const float gc = exp2f(gamma_log2(bh & 3) * 128.f);
        f32x4 S = (f32x4){0.f, 0.f, 0.f, 0.f}, kv[16];
#pragma unroll
        for (int c = 0; c < 16; ++c) kv[c] = *(const f32x4*)(KVC + ((size_t)bh * 16 + c) * 65536 + e);
#pragma unroll
        for (int c = 0; c < 16; ++c) { *(f32x4*)(SST + ((size_t)bh * 16 + c) * 65536 + e) = S; S = S * gc + kv[c]; }
        *(f32x4*)(p.out + O_RETP + (size_t)bh * 65536 + e) = S;
    }
}

DI void phase_ret_out(const P& p, LAS unsigned char* lds, int bid, int G) {
    int tid = mk_tid(p.hi); unsigned char* ws = p.ws;
    const bf16_t *RQ = (const bf16_t*)(ws + WS_RQ), *RK = (const bf16_t*)(ws + WS_RK), *RV = (const bf16_t*)(ws + WS_RV);
    const float* SST = (const float*)(ws + WS_SST); const bf16_t* RGS = (const bf16_t*)(ws + WS_RGS); bf16_t* MIX = (bf16_t*)(ws + WS_MIX);
    LAS float* As = (LAS float*)lds;
    LAS float* R1 = As + 128 * 129;
    for (int unit = bid; unit < 256; unit += G) {
        const int b = unit >> 6, h = (unit >> 4) & 3, c = unit & 15; const float lg = gamma_log2(h);
        const size_t m0 = (size_t)b * 2048 + c * 128;
        {
            LAS float* qs = R1; LAS float* ks = R1 + 128 * 65;
            const int ty = tid >> 4, tx = tid & 15;
            float acc[4][8];
#pragma unroll
            for (int a = 0; a < 4; ++a)
#pragma unroll
                for (int e = 0; e < 8; ++e) acc[a][e] = 0.f;
            for (int dc = 0; dc < 4; ++dc) {
                __syncthreads();
#pragma unroll 4
                for (int i = 0; i < 16; ++i) { const int idx = tid + 512 * i, r = idx >> 6, d = idx & 63;
                    qs[r * 65 + d] = bf2f(RQ[(m0 + r) * 1024 + h * 256 + dc * 64 + d]); ks[r * 65 + d] = bf2f(RK[(m0 + r) * 1024 + h * 256 + dc * 64 + d]); }
                __syncthreads();
                for (int d = 0; d < 64; ++d) {
                    float qv[4], kv[8];
#pragma unroll
                    for (int a = 0; a < 4; ++a) qv[a] = qs[(ty * 4 + a) * 65 + d];
#pragma unroll
                    for (int e = 0; e < 8; ++e) kv[e] = ks[(tx * 8 + e) * 65 + d];
#pragma unroll
                    for (int a = 0; a < 4; ++a)
#pragma unroll
                        for (int e = 0; e < 8; ++e) acc[a][e] += qv[a] * kv[e];
                }
            }
#pragma unroll
            for (int a = 0; a < 4; ++a)
#pragma unroll
                for (int e = 0; e < 8; ++e) { const int i = ty * 4 + a, j = tx * 8 + e; As[i * 129 + j] = (j <= i) ? acc[a][e] * exp2f(lg * (float)(i - j)) : 0.f; }
        }
        const int ty = tid >> 5, tx = tid & 31;
        float o[8][8];
#pragma unroll
        for (int a = 0; a < 8; ++a)
#pragma unroll
            for (int e = 0; e < 8; ++e) o[a][e] = 0.f;
        LAS float* bs = R1; LAS float* qc = R1 + 32 * 256;
        for (int jc = 0; jc < 4; ++jc) {
            __syncthreads();
#pragma unroll 4
            for (int i = 0; i < 16; ++i) { const int idx = tid + 512 * i, j = idx >> 8, e = idx & 255; bs[idx] = bf2f(RV[(m0 + jc * 32 + j) * 1024 + h * 256 + e]); }
            __syncthreads();
            for (int j = 0; j < 32; ++j) {
                float av[8]; f32x4 vr[2];
#pragma unroll
                for (int a = 0; a < 8; ++a) av[a] = As[(ty * 8 + a) * 129 + jc * 32 + j];
                vr[0] = *(const LAS f32x4*)(bs + j * 256 + tx * 8); vr[1] = *(const LAS f32x4*)(bs + j * 256 + tx * 8 + 4);
#pragma unroll
                for (int a = 0; a < 8; ++a)
#pragma unroll
                    for (int e = 0; e < 8; ++e) o[a][e] += av[a] * vr[e >> 2][e & 3];
            }
        }
        const float* S = SST + (size_t)unit * 65536;
        for (int dc = 0; dc < 8; ++dc) {
            __syncthreads();
#pragma unroll 4
            for (int i = 0; i < 16; ++i) { const int idx = tid + 512 * i, j = idx >> 8, e = idx & 255; bs[idx] = S[(dc * 32 + j) * 256 + e]; }
#pragma unroll 4
            for (int i = 0; i < 8; ++i) { const int idx = tid + 512 * i, r = idx >> 5, d = idx & 31; qc[r * 33 + d] = bf2f(RQ[(m0 + r) * 1024 + h * 256 + dc * 32 + d]) * exp2f(lg * (float)(r + 1)); }
            __syncthreads();
            for (int j = 0; j < 32; ++j) {
                float av[8]; f32x4 vr[2];
#pragma unroll
                for (int a = 0; a < 8; ++a) av[a] = qc[(ty * 8 + a) * 33 + j];
                vr[0] = *(const LAS f32x4*)(bs + j * 256 + tx * 8); vr[1] = *(const LAS f32x4*)(bs + j * 256 + tx * 8 + 4);
#pragma unroll
                for (int a = 0; a < 8; ++a)
#pragma unroll
                    for (int e = 0; e < 8; ++e) o[a][e] += av[a] * vr[e >> 2][e & 3];
            }
        }
#pragma unroll
        for (int a = 0; a < 8; ++a) {
            float ss = 0.f;
#pragma unroll
            for (int e = 0; e < 8; ++e) ss += o[a][e] * o[a][e];
#pragma unroll
            for (int q = 1; q < 32; q <<= 1) ss += __shfl_xor(ss, q);
            const float r = rsqrtf(ss * (1.f / 256.f) + EPS); const size_t m = m0 + ty * 8 + a;
            float rgv[8]; load8(RGS + m * 1024 + h * 256 + tx * 8, rgv); const float* gn = p.ret_gn + h * 256 + tx * 8;
            u32x4 w; float y[8];
#pragma unroll
            for (int e = 0; e < 8; ++e) y[e] = o[a][e] * r * gn[e] * rgv[e];
            w.x = pk2(y[0], y[1]); w.y = pk2(y[2], y[3]); w.z = pk2(y[4], y[5]); w.w = pk2(y[6], y[7]);
            *(u32x4*)(MIX + m * 2048 + h * 256 + tx * 8) = w;
        }
        __syncthreads();
    }
}

DI void ret_sample_wave(const P& p, LAS unsigned char* scr, int unit, int lane) {
    unsigned char* ws = p.ws;
    const bf16_t *RQ = (const bf16_t*)(ws + WS_RQ), *RK = (const bf16_t*)(ws + WS_RK), *RV = (const bf16_t*)(ws + WS_RV), *RGS = (const bf16_t*)(ws + WS_RGS); bf16_t* MIX = (bf16_t*)(ws + WS_MIX);
    LAS bf16_t* qk = (LAS bf16_t*)scr; LAS float* am = (LAS float*)(scr + 8192);
    const int b = unit >> 2, h = unit & 3; const size_t m0 = NP + (size_t)b * 8; const float g8 = exp2f(gamma_log2(h) * 8.f);
    f32x4 vreg[8];
    {   f32x4 q4[8], k4[8];
#pragma unroll
        for (int t = 0; t < 8; ++t) { const size_t o = (m0 + t) * 1024 + h * 256 + lane * 4;
            const u32x2 qw = *(const u32x2*)(RQ + o), kw = *(const u32x2*)(RK + o), vw = *(const u32x2*)(RV + o);
            q4[t] = (f32x4){__uint_as_float(qw.x << 16), __uint_as_float(qw.x & 0xffff0000u), __uint_as_float(qw.y << 16), __uint_as_float(qw.y & 0xffff0000u)};
            k4[t] = (f32x4){__uint_as_float(kw.x << 16), __uint_as_float(kw.x & 0xffff0000u), __uint_as_float(kw.y << 16), __uint_as_float(kw.y & 0xffff0000u)};
            vreg[t] = (f32x4){__uint_as_float(vw.x << 16), __uint_as_float(vw.x & 0xffff0000u), __uint_as_float(vw.y << 16), __uint_as_float(vw.y & 0xffff0000u)};
            LAS bf16_t* row = qk + (lane * 4) * 16 + t;
            row[0] = (bf16_t)(qw.x & 0xffffu); row[16] = (bf16_t)(qw.x >> 16); row[32] = (bf16_t)(qw.y & 0xffffu); row[48] = (bf16_t)(qw.y >> 16);
            row[8] = (bf16_t)(kw.x & 0xffffu); row[24] = (bf16_t)(kw.x >> 16); row[40] = (bf16_t)(kw.y & 0xffffu); row[56] = (bf16_t)(kw.y >> 16); }
#pragma unroll
        for (int t = 0; t < 8; ++t)
#pragma unroll
            for (int j = 0; j < 8; ++j) { float a = 0.f;
                if (j <= t) { const f32x4 pr = q4[t] * k4[j]; a = wave_sum((pr[0] + pr[1]) + (pr[2] + pr[3])); }
                if (lane == 0) am[t * 8 + j] = a; }
    }
    LDS_WAIT();
    f32x4 oacc[8];
#pragma unroll
    for (int t = 0; t < 8; ++t) oacc[t] = (f32x4){0.f, 0.f, 0.f, 0.f};
    const float* S0 = p.state_ret + (size_t)unit * 65536; float* Sn = p.out + O_RETS + (size_t)unit * 65536;
    f32x4 bA[8], bB[8], bC[8];
    auto ld = [&](f32x4 (&buf)[8], int d0) {
#pragma unroll
        for (int e = 0; e < 8; ++e) buf[e] = __builtin_nontemporal_load((const f32x4*)(S0 + (d0 + e) * 256 + lane * 4));
        asm volatile("" ::: "memory"); };
    auto use = [&](const f32x4 (&buf)[8], int d0) {
#pragma unroll
        for (int e = 0; e < 8; ++e) { const int d = d0 + e;
            const u32x4 wq = *(const LAS u32x4*)(qk + d * 16), wk = *(const LAS u32x4*)(qk + d * 16 + 8);
            f32x4 sn = buf[e];
#pragma unroll
            for (int i = 0; i < 4; ++i) { const unsigned uq = (unsigned)__builtin_amdgcn_readfirstlane((int)wq[i]), uk = (unsigned)__builtin_amdgcn_readfirstlane((int)wk[i]);
                const float q0 = __uint_as_float(uq << 16), q1 = __uint_as_float(uq & 0xffff0000u), k0 = __uint_as_float(uk << 16), k1 = __uint_as_float(uk & 0xffff0000u);
                oacc[2 * i] += buf[e] * q0; oacc[2 * i + 1] += buf[e] * q1; sn += vreg[2 * i] * k0; sn += vreg[2 * i + 1] * k1; }
            __builtin_nontemporal_store(sn * g8, (f32x4*)(Sn + d * 256 + lane * 4)); }
        asm volatile("" ::: "memory"); };
    ld(bA, 0); ld(bB, 8);
#pragma unroll 1
    for (int d0 = 0; d0 < 240; d0 += 24) {
        ld(bC, d0 + 16); use(bA, d0);
        ld(bA, d0 + 24); use(bB, d0 + 8);
        ld(bB, d0 + 32); use(bC, d0 + 16);
    }
    use(bA, 240); use(bB, 248);
#pragma unroll
    for (int t = 0; t < 8; ++t) { f32x4 o = oacc[t];
#pragma unroll
        for (int j = 0; j <= t; ++j) o += vreg[j] * am[t * 8 + j];
        const float ss = wave_sum((o.x * o.x + o.y * o.y) + (o.z * o.z + o.w * o.w)); const float r = rsqrtf(ss * (1.f / 256.f) + EPS);
        const size_t m = m0 + t; const u32x2 rgb = *(const u32x2*)(RGS + m * 1024 + h * 256 + lane * 4); const f32x4 gn = *(const f32x4*)(p.ret_gn + h * 256 + lane * 4);
        const f32x4 rg = (f32x4){__uint_as_float(rgb.x << 16), __uint_as_float(rgb.x & 0xffff0000u), __uint_as_float(rgb.y << 16), __uint_as_float(rgb.y & 0xffff0000u)};
        u32x2 w; w.x = pk2(o.x * r * gn.x * rg.x, o.y * r * gn.y * rg.y); w.y = pk2(o.z * r * gn.z * rg.z, o.w * r * gn.w * rg.w);
        *(u32x2*)(MIX + m * 2048 + h * 256 + lane * 4) = w; }
}
DI void phase_ret_sample(const P& p, LAS unsigned char* lds, int bid, int G) {
    int tid = mk_tid(p.hi); const int lane = tid & 63, wave = tid >> 6; unsigned char* ws = p.ws;
    const bf16_t *RQ = (const bf16_t*)(ws + WS_RQ), *RK = (const bf16_t*)(ws + WS_RK), *RV = (const bf16_t*)(ws + WS_RV);
    const bf16_t* RGS = (const bf16_t*)(ws + WS_RGS); bf16_t* MIX = (bf16_t*)(ws + WS_MIX);
    LAS float* qs = (LAS float*)lds; LAS float* ks = qs + 2048; LAS float* kraw = ks + 2048; LAS float* vs = kraw + 2048; LAS float* Am = vs + 2048; LAS float* red = Am + 64;
    for (int unit = bid; unit < 512; unit += G) {
        const int b = unit >> 2, h = unit & 3; const float lg = gamma_log2(h); const size_t m0 = NP + (size_t)b * 8;
        __syncthreads();
        for (int i = tid; i < 2048; i += 512) { const int t = i >> 8, d = i & 255; const size_t o = (m0 + t) * 1024 + h * 256 + d;
            const float kv = bf2f(RK[o]); qs[i] = bf2f(RQ[o]); kraw[i] = kv; ks[i] = kv; vs[i] = bf2f(RV[o]); }
        __syncthreads();
        { const int t = wave;
#pragma unroll
          for (int j = 0; j < 8; ++j) { float s = 0.f;
#pragma unroll
              for (int q = 0; q < 4; ++q) s += qs[t * 256 + lane + 64 * q] * kraw[j * 256 + lane + 64 * q];
              s = wave_sum(s); if (lane == 0) Am[t * 8 + j] = (j <= t) ? s : 0.f; } }
        f32x4 vreg[8], oacc[8];
#pragma unroll
        for (int t = 0; t < 8; ++t) { vreg[t] = *(const LAS f32x4*)(vs + t * 256 + lane * 4); oacc[t] = (f32x4){0.f, 0.f, 0.f, 0.f}; }
        const float g8 = exp2f(lg * 8.f);
        const float* S0 = p.state_ret + (size_t)unit * 65536; float* Sn = p.out + O_RETS + (size_t)unit * 65536;
        f32x4 cur[8], nxt[8];
#pragma unroll
        for (int e = 0; e < 8; ++e) cur[e] = __builtin_nontemporal_load((const f32x4*)(S0 + (wave * 32 + e) * 256 + lane * 4));
#pragma unroll 1
        for (int d0 = wave * 32; d0 < wave * 32 + 32; d0 += 8) {
            const int dn = (d0 + 8 < wave * 32 + 32) ? d0 + 8 : d0;
#pragma unroll
            for (int e = 0; e < 8; ++e) nxt[e] = __builtin_nontemporal_load((const f32x4*)(S0 + (dn + e) * 256 + lane * 4));
            asm volatile("" ::: "memory");
#pragma unroll
            for (int e = 0; e < 8; ++e) { const int d = d0 + e; f32x4 sn = cur[e];
#pragma unroll
                for (int t = 0; t < 8; ++t) { oacc[t] += cur[e] * qs[t * 256 + d]; sn += vreg[t] * ks[t * 256 + d]; }
                __builtin_nontemporal_store(sn * g8, (f32x4*)(Sn + d * 256 + lane * 4)); }
            asm volatile("" ::: "memory");
#pragma unroll
            for (int e = 0; e < 8; ++e) cur[e] = nxt[e];
        }
#pragma unroll
        for (int t = 0; t < 8; ++t) *(LAS f32x4*)(red + (wave * 8 + t) * 256 + lane * 4) = oacc[t];
        __syncthreads();
        { const int t = wave; f32x4 o = (f32x4){0.f, 0.f, 0.f, 0.f};
#pragma unroll
          for (int w = 0; w < 8; ++w) o += *(const LAS f32x4*)(red + (w * 8 + t) * 256 + lane * 4);
#pragma unroll
          for (int j = 0; j < 8; ++j) o += vreg[j] * Am[t * 8 + j];
          const float ss = wave_sum((o.x * o.x + o.y * o.y) + (o.z * o.z + o.w * o.w)); const float r = rsqrtf(ss * (1.f / 256.f) + EPS);
          const size_t m = m0 + t; const u32x2 rgb = *(const u32x2*)(RGS + m * 1024 + h * 256 + lane * 4); const f32x4 gn = *(const f32x4*)(p.ret_gn + h * 256 + lane * 4);
          const f32x4 rg = (f32x4){__uint_as_float(rgb.x << 16), __uint_as_float(rgb.x & 0xffff0000u), __uint_as_float(rgb.y << 16), __uint_as_float(rgb.y & 0xffff0000u)};
          u32x2 w; w.x = pk2(o.x * r * gn.x * rg.x, o.y * r * gn.y * rg.y); w.y = pk2(o.z * r * gn.z * rg.z, o.w * r * gn.w * rg.w);
          *(u32x2*)(MIX + m * 2048 + h * 256 + lane * 4) = w; }
    }
}

DI void phase_cmp_l2(const P& p, LAS unsigned char* lds, int bid, int G) {
    int tid = mk_tid(p.hi); const int lane = tid & 63, wave = tid >> 6; unsigned char* ws = p.ws;
    const bf16_t* HPRE = (const bf16_t*)(ws + WS_HPRE); const float* PEB = (const float*)(ws + CTL_PEB);
    bf16_t *KC = (bf16_t*)(ws + WS_KC), *VC = (bf16_t*)(ws + WS_VC), *VCT = (bf16_t*)(ws + WS_VCT);
    LAS float* hid = (LAS float*)lds + wave * 256;
    const int gw = bid * 8 + wave, NGW = G * 8;
    for (int task = gw; task < 2 * NBB * 4 * 128; task += NGW) {
        const int c = task / (NBB * 512), rem = task % (NBB * 512), i = rem & 127; const size_t row = rem;
        bf16_t* dst = (c ? VC : KC) + row * 64 + lane;
        bf16_t* dstT = VCT + ((row >> 7) * 64 + lane) * 128 + i;
        if (i == 127) { *dst = 0; if (c) *dstT = 0; continue; }
        const bf16_t* h0 = HPRE + ((size_t)c * CM + row) * 512; const bf16_t* h1 = h0 + 512 + 256;
#pragma unroll
        for (int q = 0; q < 4; ++q) { const int hh = lane + 64 * q; hid[hh] = silu_f(bf2f(h0[hh]) + bf2f(h1[hh]) + PEB[c * 256 + hh] + p.cmp_b1[c * 256 + hh]); }
        LDS_WAIT();
        const float* w2 = p.cmp_w2 + (size_t)c * 256 * 64 + lane; float acc = p.cmp_b2[c * 64 + lane];
#pragma unroll 8
        for (int hh = 0; hh < 256; ++hh) acc += hid[hh] * w2[hh * 64];
        if (c == 0) { const float r = rsqrtf(wave_sum(acc * acc) * (1.f / 64.f) + EPS); acc = acc * r * p.k_norm_cmp[lane]; }
        *dst = (bf16_t)f2bf(acc); if (c) *dstT = (bf16_t)f2bf(acc);
        LDS_WAIT();
    }
}

DI float ld_elem(const bf16_t* p) { return bf2f(*p); }
DI float ld_elem(const float* p) { return *p; }

template <class T> DI void dot4_row(const LAS float* qs, const T* kr, float (&s)[4]) {
#pragma unroll 1
    for (int d8 = 0; d8 < 8; ++d8) { float kv[8]; load8(kr + d8 * 8, kv); asm volatile("" ::: "memory");
#pragma unroll
        for (int r = 0; r < 4; ++r) { const f32x4 qa = *(const LAS f32x4*)(qs + r * 64 + d8 * 8), qb = *(const LAS f32x4*)(qs + r * 64 + d8 * 8 + 4);
            s[r] += (qa.x * kv[0] + qa.y * kv[1]) + (qa.z * kv[2] + qa.w * kv[3]) + (qb.x * kv[4] + qb.y * kv[5]) + (qb.z * kv[6] + qb.w * kv[7]); } }
}
struct AttnState { float m[4], l[4], o[4]; };
template <class T> DI void attend_chunk(AttnState& st, const LAS float* qs, LAS float* ps, const T* kbase, const T* vbase, int stride, int nkeys, int dist0, int dstep, int maxdist, const float (&slope)[4], int lane) {
    const int dist = dist0 - lane * dstep; const bool valid = lane < nkeys && dist >= 0 && dist < maxdist;
    float s[4] = {0.f, 0.f, 0.f, 0.f};
    if (valid) dot4_row<T>(qs, kbase + (size_t)lane * stride, s);
    float pr[4];
#pragma unroll
    for (int r = 0; r < 4; ++r) { const float sc = valid ? s[r] - slope[r] * (float)dist : -INFINITY; const float cm = wave_max(sc); const float mn = fmaxf(st.m[r], cm);
        const float alpha = (mn == -INFINITY) ? 1.f : __expf(st.m[r] - mn); pr[r] = valid ? __expf(sc - mn) : 0.f;
        st.l[r] = st.l[r] * alpha + wave_sum(pr[r]); st.o[r] *= alpha; st.m[r] = mn; }
    *(LAS f32x4*)(ps + lane * 4) = (f32x4){pr[0], pr[1], pr[2], pr[3]};
    LDS_WAIT();
#pragma unroll 4
    for (int kk = 0; kk < nkeys; ++kk) { const float v = ld_elem(vbase + (size_t)kk * stride + lane); const f32x4 pv = *(const LAS f32x4*)(ps + kk * 4);
        st.o[0] += pv.x * v; st.o[1] += pv.y * v; st.o[2] += pv.z * v; st.o[3] += pv.w * v; }
    LDS_WAIT();
}
DI void attn_reset(AttnState& st) {
#pragma unroll
    for (int r = 0; r < 4; ++r) { st.m[r] = -INFINITY; st.l[r] = 0.f; st.o[r] = 0.f; } }

DI void phase_attn(const P& p, LAS unsigned char* lds, int bid, int G) {
    int tid = mk_tid(p.hi); const int lane = tid & 63, wave = tid >> 6; unsigned char* ws = p.ws;
    const bf16_t *NQ = (const bf16_t*)(ws + WS_NQ), *KSLC = (const bf16_t*)(ws + WS_KSLC), *VSLC = (const bf16_t*)(ws + WS_VSLC), *KWIN = (const bf16_t*)(ws + WS_KWIN), *VWIN = (const bf16_t*)(ws + WS_VWIN);
    const bf16_t *KC = (const bf16_t*)(ws + WS_KC), *VC = (const bf16_t*)(ws + WS_VC); const float* GATES = (const float*)(ws + WS_GATES); bf16_t* MIX = (bf16_t*)(ws + WS_MIX);
    LAS float* qs = (LAS float*)lds + wave * 1024; LAS float* ps = qs + 256; LAS float* pcs = ps + 256;
    const int gw = bid * 8 + wave, NGW = G * 8;
#pragma unroll 1
    for (int task = NP * 4 + gw; task < MT * 4; task += NGW) {
        const int m = task >> 2, g = task & 3; const bool prompt = m < NP;
        const int b = prompt ? (m >> 11) : ((m - NP) >> 3), t = prompt ? (m & 2047) : ((m - NP) & 7), qpos = prompt ? t : 2048 + t, bb = prompt ? b : 4 + b;
        float slope[4];
#pragma unroll
        for (int r = 0; r < 4; ++r) { slope[r] = exp2f(-0.5f * (float)(g * 4 + r + 1)); qs[r * 64 + lane] = bf2f(NQ[(size_t)m * 1024 + (g * 4 + r) * 64 + lane]); }
        LDS_WAIT();
        float res[4] = {0.f, 0.f, 0.f, 0.f};
        const float* gt = GATES + (size_t)m * 48 + g * 12;
        AttnState st;
        const bf16_t* kc = KC + ((size_t)bb * 4 + g) * 128 * 64; const bf16_t* vc = VC + ((size_t)bb * 4 + g) * 128 * 64;
        float pc0[4], pc1[4];
        {
            float s0[4] = {0.f, 0.f, 0.f, 0.f}, s1[4] = {0.f, 0.f, 0.f, 0.f};
            const int d0 = qpos - 31 - 16 * lane, d1 = d0 - 1024; const bool v0 = d0 >= 0, v1 = d1 >= 0 && lane < 63;
            if (v0) dot4_row<bf16_t>(qs, kc + lane * 64, s0);
            if (v1) dot4_row<bf16_t>(qs, kc + (64 + lane) * 64, s1);
            float psum0 = 0.f, psum1 = 0.f;
#pragma unroll
            for (int r = 0; r < 4; ++r) { const float a0 = v0 ? s0[r] - slope[r] * (float)d0 : -INFINITY, a1 = v1 ? s1[r] - slope[r] * (float)d1 : -INFINITY;
                float mx = wave_max(fmaxf(a0, a1)); if (mx == -INFINITY) mx = 0.f;
                const float e0 = v0 ? __expf(a0 - mx) : 0.f, e1 = v1 ? __expf(a1 - mx) : 0.f; const float inv = 1.f / fmaxf(wave_sum(e0 + e1), 1e-30f);
                pc0[r] = e0 * inv; pc1[r] = e1 * inv; psum0 += pc0[r]; psum1 += pc1[r]; }
            pcs[lane] = psum0; pcs[64 + lane] = psum1; if (lane < 4) pcs[128 + lane] = 0.f;
            float oc[4] = {0.f, 0.f, 0.f, 0.f};
            *(LAS f32x4*)(ps + lane * 4) = (f32x4){pc0[0], pc0[1], pc0[2], pc0[3]}; LDS_WAIT();
#pragma unroll 4
            for (int kk = 0; kk < 64; ++kk) { const float v = bf2f(vc[kk * 64 + lane]); const f32x4 pv = *(const LAS f32x4*)(ps + kk * 4); oc[0] += pv.x * v; oc[1] += pv.y * v; oc[2] += pv.z * v; oc[3] += pv.w * v; }
            LDS_WAIT();
            *(LAS f32x4*)(ps + lane * 4) = (f32x4){pc1[0], pc1[1], pc1[2], pc1[3]}; LDS_WAIT();
#pragma unroll 3
            for (int kk = 0; kk < 63; ++kk) { const float v = bf2f(vc[(64 + kk) * 64 + lane]); const f32x4 pv = *(const LAS f32x4*)(ps + kk * 4); oc[0] += pv.x * v; oc[1] += pv.y * v; oc[2] += pv.z * v; oc[3] += pv.w * v; }
            LDS_WAIT();
#pragma unroll
            for (int r = 0; r < 4; ++r) res[r] += gt[r * 3 + 0] * oc[r];
        }
        unsigned long long selmask;
        {
            const int cur = qpos >> 6, j = lane; float imp = 0.f;
            if (j < 33) { imp = pcs[4 * j] + pcs[4 * j + 1] + pcs[4 * j + 2] + 0.5f * pcs[4 * j + 3]; if (j > 0) imp += 0.5f * pcs[4 * j - 1]; }
            const bool vj = j <= cur && j < 33, forced = (j == 0) || (j == cur) || (j == cur - 1);
            const float score = !vj ? -INFINITY : (forced ? INFINITY : imp);
            int rank = 0;
            for (int q = 0; q < 33; ++q) { const float sq = __shfl(score, q); rank += (sq > score || (sq == score && q < j)) ? 1 : 0; }
            selmask = __ballot(vj && rank < 16);
        }
        attn_reset(st);
#pragma unroll 1
        for (int j = 0; j < 33; ++j) {
            if (!((selmask >> j) & 1ull)) continue;
            if (prompt) { const size_t r0 = ((size_t)b * 2048 + 64 * j) * 256 + g * 64; attend_chunk<bf16_t>(st, qs, ps, KSLC + r0, VSLC + r0, 256, 64, qpos - 64 * j, 1, 1 << 30, slope, lane); }
            else if (j < 32) { const int page = p.page_table[b * 16 + (j >> 1)]; const float* r0 = p.cache_kv + ((size_t)page * 128 + (j & 1) * 64) * 1024 + g * 64;
                attend_chunk<float>(st, qs, ps, r0 + 512, r0 + 768, 1024, 64, qpos - 64 * j, 1, 1 << 30, slope, lane); }
            else { const size_t r0 = ((size_t)NP + b * 8) * 256 + g * 64; attend_chunk<bf16_t>(st, qs, ps, KSLC + r0, VSLC + r0, 256, 8, qpos - 2048, 1, 1 << 30, slope, lane); }
        }
#pragma unroll
        for (int r = 0; r < 4; ++r) res[r] += gt[r * 3 + 1] * st.o[r] / fmaxf(st.l[r], 1e-30f);
        attn_reset(st);
        if (prompt) { const int k0 = t - 511 > 0 ? t - 511 : 0;
#pragma unroll 1
            for (int c0 = k0; c0 <= t; c0 += 64) { const size_t r0 = ((size_t)b * 2048 + c0) * 256 + g * 64; const int nk = (t - c0 + 1) < 64 ? (t - c0 + 1) : 64;
                attend_chunk<bf16_t>(st, qs, ps, KWIN + r0, VWIN + r0, 256, nk, t - c0, 1, 512, slope, lane); } }
        else {
#pragma unroll 1
            for (int s0 = 0; s0 < 512; s0 += 64) { const float* r0 = p.cache_win + ((size_t)b * 512 + s0) * 512 + g * 64;
                attend_chunk<float>(st, qs, ps, r0, r0 + 256, 512, 64, qpos - (1536 + s0), 1, 512, slope, lane); }
            const size_t r0 = ((size_t)NP + b * 8) * 256 + g * 64; attend_chunk<bf16_t>(st, qs, ps, KWIN + r0, VWIN + r0, 256, 8, qpos - 2048, 1, 512, slope, lane); }
#pragma unroll
        for (int r = 0; r < 4; ++r) { res[r] += gt[r * 3 + 2] * st.o[r] / fmaxf(st.l[r], 1e-30f); MIX[(size_t)m * 2048 + 1024 + (g * 4 + r) * 64 + lane] = (bf16_t)f2bf(res[r]); }
        LDS_WAIT();
    }
}

DI void phase_conv(const P& p, int bid, int G) {
    int tid = mk_tid(p.hi); unsigned char* ws = p.ws;
    const bf16_t* U = (const bf16_t*)(ws + WS_U); bf16_t* ACT = (bf16_t*)(ws + WS_ACT);
    for (size_t i = (size_t)bid * 512 + tid; i < (size_t)MT * (FF / 4); i += (size_t)G * 512) {
        const int m = (int)(i / (FF / 4)), n = (int)(i % (FF / 4)) * 4;
        const bool prompt = m < NP; const int b = prompt ? (m >> 11) : ((m - NP) >> 3), t = prompt ? (m & 2047) : ((m - NP) & 7);
        float c2[2][4];
#pragma unroll
        for (int hf = 0; hf < 2; ++hf) { const int col = n + hf * FF;
            const f32x4 w0 = *(const f32x4*)(p.conv_w + col), w1 = *(const f32x4*)(p.conv_w + FF2 + col), w2 = *(const f32x4*)(p.conv_w + 2 * FF2 + col), cb = *(const f32x4*)(p.conv_b + col);
            f32x4 u0, u1, u2;
            { const u32x2 r = *(const u32x2*)(U + (size_t)m * FF2 + col); u2 = (f32x4){__uint_as_float(r.x << 16), __uint_as_float(r.x & 0xffff0000u), __uint_as_float(r.y << 16), __uint_as_float(r.y & 0xffff0000u)}; }
            if (t >= 1) { const u32x2 r = *(const u32x2*)(U + (size_t)(m - 1) * FF2 + col); u1 = (f32x4){__uint_as_float(r.x << 16), __uint_as_float(r.x & 0xffff0000u), __uint_as_float(r.y << 16), __uint_as_float(r.y & 0xffff0000u)}; }
            else if (prompt) u1 = (f32x4){0.f, 0.f, 0.f, 0.f}; else u1 = *(const f32x4*)(p.state_conv + ((size_t)b * 2 + 1) * FF2 + col);
            if (t >= 2) { const u32x2 r = *(const u32x2*)(U + (size_t)(m - 2) * FF2 + col); u0 = (f32x4){__uint_as_float(r.x << 16), __uint_as_float(r.x & 0xffff0000u), __uint_as_float(r.y << 16), __uint_as_float(r.y & 0xffff0000u)}; }
            else if (prompt) u0 = (f32x4){0.f, 0.f, 0.f, 0.f}; else u0 = *(const f32x4*)(p.state_conv + ((size_t)b * 2 + t) * FF2 + col);
            const f32x4 c = cb + w2 * u2 + w1 * u1 + w0 * u0; c2[hf][0] = c.x; c2[hf][1] = c.y; c2[hf][2] = c.z; c2[hf][3] = c.w; }
        u32x2 w; w.x = pk2(silu_f(c2[0][0]) * c2[1][0], silu_f(c2[0][1]) * c2[1][1]); w.y = pk2(silu_f(c2[0][2]) * c2[1][2], silu_f(c2[0][3]) * c2[1][3]);
        *(u32x2*)(ACT + (size_t)m * FF + n) = w;
    }
}


typedef short bf16x8 __attribute__((ext_vector_type(8)));
typedef short s16x4 __attribute__((ext_vector_type(4)));
typedef float f32x16 __attribute__((ext_vector_type(16)));
typedef __bf16 bf16x2v __attribute__((ext_vector_type(2)));
typedef float f32x2v __attribute__((ext_vector_type(2)));
#define MFMA32(a, b, c) __builtin_amdgcn_mfma_f32_32x32x16_bf16((a), (b), (c), 0, 0, 0)
constexpr int TS = 72;
constexpr float LOG2E = 1.4426950408889634f;
DI unsigned cvt2(float a, float b) { return __builtin_bit_cast(unsigned, __builtin_convertvector((f32x2v){a, b}, bf16x2v)); }
template <int S> DI bf16x8 pack_step(const f32x16& x) {
    u32x4 p; p.x = cvt2(x[8 * S + 0], x[8 * S + 1]); p.y = cvt2(x[8 * S + 2], x[8 * S + 3]); p.z = cvt2(x[8 * S + 4], x[8 * S + 5]); p.w = cvt2(x[8 * S + 6], x[8 * S + 7]);
    return __builtin_bit_cast(bf16x8, p); }
DI float xor32(float v) { return __shfl_xor(v, 32); }

struct TileRegs { u32x4 k, v; };
DI TileRegs tile_load(const bf16_t* ksrc, const bf16_t* vtsrc, int ldv, int tid) {
    TileRegs r; const int row = tid >> 3, ch = tid & 7;
    r.k = *(const u32x4*)(ksrc + (size_t)row * 64 + ch * 8); r.v = *(const u32x4*)(vtsrc + (size_t)row * ldv + ch * 8); return r; }
DI void tile_store(LAS bf16_t* kt, LAS bf16_t* vt, const TileRegs& r, int tid) {
    const int row = tid >> 3, ch = tid & 7; *(LAS u32x4*)(kt + row * TS + ch * 8) = r.k; *(LAS u32x4*)(vt + row * TS + ch * 8) = r.v; }

DI void qk_tile(const LAS bf16_t* kt, const bf16x8 (&qf)[4], int r32, int h, f32x16 (&S)[2]) {
#pragma unroll
    for (int sub = 0; sub < 2; ++sub) {
        f32x16 acc;
#pragma unroll
        for (int i = 0; i < 16; ++i) acc[i] = 0.f;
#pragma unroll
        for (int kk = 0; kk < 4; ++kk) { const bf16x8 a = *(const LAS bf16x8*)(kt + (sub * 32 + r32) * TS + kk * 16 + h * 8); acc = MFMA32(a, qf[kk], acc); }
        S[sub] = acc; }
}
DI void pv_tile(const LAS bf16_t* vt, const f32x16 (&P)[2], int r32, int h, f32x16 (&O)[2]) {
#pragma unroll
    for (int sub = 0; sub < 2; ++sub) {
        const bf16x8 p0 = pack_step<0>(P[sub]), p1 = pack_step<1>(P[sub]);
#pragma unroll
        for (int db = 0; db < 2; ++db) {
            const LAS bf16_t* vr = vt + (db * 32 + r32) * TS + sub * 32 + 4 * h;
            const s16x4 a0 = *(const LAS s16x4*)(vr), a1 = *(const LAS s16x4*)(vr + 8), b0 = *(const LAS s16x4*)(vr + 16), b1 = *(const LAS s16x4*)(vr + 24);
            O[db] = MFMA32(__builtin_shufflevector(a0, a1, 0, 1, 2, 3, 4, 5, 6, 7), p0, O[db]);
            O[db] = MFMA32(__builtin_shufflevector(b0, b1, 0, 1, 2, 3, 4, 5, 6, 7), p1, O[db]); } }
}

template <int MODE> DI void attn_tile(const LAS bf16_t* kt, const LAS bf16_t* vt, const bf16x8 (&qf)[4], int r32, int h, int d0, bool rowsel, float slope2, float& mrun, float& lrun, f32x16 (&O)[2]) {
    f32x16 S[2]; qk_tile(kt, qf, r32, h, S);
    const float c1 = -slope2 * (float)d0; float tmax = -INFINITY;
#pragma unroll
    for (int sub = 0; sub < 2; ++sub)
#pragma unroll
        for (int i = 0; i < 16; ++i) { const int off = sub * 32 + (i & 3) + 8 * (i >> 2);
            bool valid = rowsel && (off <= d0); if (MODE == 2) valid = valid && (d0 - off < 512);
            const float s2 = fmaf(S[sub][i], LOG2E, fmaf(slope2, (float)off, c1)); S[sub][i] = valid ? s2 : -INFINITY; tmax = fmaxf(tmax, S[sub][i]); }
    tmax = fmaxf(tmax, xor32(tmax));
    const float mnew = fmaxf(mrun, tmax), alpha = __builtin_amdgcn_exp2f(mrun - mnew); mrun = mnew;
    float psum = 0.f;
#pragma unroll
    for (int sub = 0; sub < 2; ++sub)
#pragma unroll
        for (int i = 0; i < 16; ++i) { const float pr = __builtin_amdgcn_exp2f(S[sub][i] - mnew); psum += pr; S[sub][i] = pr; }
    lrun = lrun * alpha + psum;
#pragma unroll
    for (int db = 0; db < 2; ++db)
#pragma unroll
        for (int i = 0; i < 16; ++i) O[db][i] *= alpha;
    pv_tile(vt, S, r32, h, O);
}

DI void phase_attn_prompt(const P& p, LAS unsigned char* lds, int bid, int G, int rnd0, int rnd1) {
    int tid = mk_tid(p.hi); const int lane = tid & 63, wave = tid >> 6, r32 = lane & 31, h = lane >> 5, ti = r32 & 7, rr = r32 >> 3;
    unsigned char* ws = p.ws;
    const bf16_t *NQ = (const bf16_t*)(ws + WS_NQ), *KSP = (const bf16_t*)(ws + WS_KSP), *VSPT = (const bf16_t*)(ws + WS_VSPT), *KWP = (const bf16_t*)(ws + WS_KWP), *VWPT = (const bf16_t*)(ws + WS_VWPT);
    const bf16_t *KC = (const bf16_t*)(ws + WS_KC), *VCT = (const bf16_t*)(ws + WS_VCT); const float* GATES = (const float*)(ws + WS_GATES); bf16_t* MIX = (bf16_t*)(ws + WS_MIX);
    LAS bf16_t* KT = (LAS bf16_t*)lds; LAS bf16_t* VT = KT + 2 * 64 * TS; LAS unsigned* UM = (LAS unsigned*)(VT + 2 * 64 * TS);
    LAS float* RES = (LAS float*)(lds + 40960) + wave * 2048 + lane;
#pragma unroll 1
    for (int rnd = rnd0; rnd < rnd1; ++rnd) {
        const int it = bid + rnd * G; if (it >= 512) break;
        const int v = (rnd & 1) ? (rnd * G + (G - 1 - it % G)) : it; if (v >= 512) continue;
        const int qt = v >> 4, b = (v >> 2) & 3, g = v & 3, t0 = qt * 64, tq = t0 + 8 * wave + ti, hd = g * 4 + rr;
        const size_t m = (size_t)b * 2048 + tq; const int bg = b * 4 + g;
        bf16x8 qf[4];
#pragma unroll
        for (int kk = 0; kk < 4; ++kk) qf[kk] = *(const bf16x8*)(NQ + m * 1024 + hd * 64 + kk * 16 + h * 8);
        const float slope2 = exp2f(-0.5f * (float)(hd + 1)) * LOG2E;
        const float gt0 = GATES[m * 48 + hd * 3 + 0], gt1 = GATES[m * 48 + hd * 3 + 1], gt2 = GATES[m * 48 + hd * 3 + 2];
        if (tid == 0) UM[0] = 0u;
        unsigned rowmask;
        {
            __syncthreads();
            { const bf16_t* kc = KC + (size_t)bg * 128 * 64; const bf16_t* vc = VCT + (size_t)bg * 64 * 128;
              const TileRegs a = tile_load(kc, vc, 128, tid), c = tile_load(kc + 64 * 64, vc + 64, 128, tid);
              tile_store(KT, VT, a, tid); tile_store(KT + 64 * TS, VT + 64 * TS, c, tid); }
            __syncthreads();
            f32x16 S[4];
            { f32x16 T2[2]; qk_tile(KT, qf, r32, h, T2); S[0] = T2[0]; S[1] = T2[1]; qk_tile(KT + 64 * TS, qf, r32, h, T2); S[2] = T2[0]; S[3] = T2[1]; }
            const int dq = tq - 31 - 64 * h; const float c1 = -slope2 * (float)dq; float tmax = -INFINITY;
#pragma unroll
            for (int s4 = 0; s4 < 4; ++s4)
#pragma unroll
                for (int i = 0; i < 16; ++i) { const int off16 = 16 * (s4 * 32 + (i & 3) + 8 * (i >> 2));
                    const float s2 = fmaf(S[s4][i], LOG2E, fmaf(slope2, (float)off16, c1)); S[s4][i] = (off16 <= dq) ? s2 : -INFINITY; tmax = fmaxf(tmax, S[s4][i]); }
            tmax = fmaxf(tmax, xor32(tmax));
            const float mx = fmaxf(tmax, -1e30f); float psum = 0.f;
#pragma unroll
            for (int s4 = 0; s4 < 4; ++s4)
#pragma unroll
                for (int i = 0; i < 16; ++i) { const float pr = __builtin_amdgcn_exp2f(S[s4][i] - mx); psum += pr; S[s4][i] = pr; }
            psum += xor32(psum);
            const float inv = 1.f / fmaxf(psum, 1e-30f);
#pragma unroll
            for (int s4 = 0; s4 < 4; ++s4)
#pragma unroll
                for (int i = 0; i < 16; ++i) S[s4][i] *= inv;
            f32x16 O[2];
#pragma unroll
            for (int db = 0; db < 2; ++db)
#pragma unroll
                for (int i = 0; i < 16; ++i) O[db][i] = 0.f;
            { f32x16 T2[2]; T2[0] = S[0]; T2[1] = S[1]; pv_tile(VT, T2, r32, h, O); T2[0] = S[2]; T2[1] = S[3]; pv_tile(VT + 64 * TS, T2, r32, h, O); }
#pragma unroll
            for (int db = 0; db < 2; ++db)
#pragma unroll
                for (int i = 0; i < 16; ++i) RES[64 * (db * 16 + i)] = gt0 * O[db][i];
            float imp[16], tl[16];
#pragma unroll
            for (int k = 0; k < 16; ++k) { const f32x16& T = S[k >> 2]; const int q = (k & 3) * 4; tl[k] = T[q + 3]; imp[k] = (T[q] + T[q + 1]) + (T[q + 2] + 0.5f * T[q + 3]); }
#pragma unroll
            for (int k = 0; k < 16; ++k) tl[k] = xor32(tl[k]);
#pragma unroll
            for (int k = 0; k < 16; ++k) { const float prev = h ? tl[k] : (k > 0 ? tl[k > 0 ? k - 1 : 0] : 0.f); float x = imp[k] + 0.5f * prev; x += __shfl_xor(x, 8); x += __shfl_xor(x, 16); imp[k] = x; }
            const int cur = tq >> 6;
            float sc[16], sp[16];
#pragma unroll
            for (int k = 0; k < 16; ++k) { const int j = 2 * k + h; const bool vj = j <= cur, forced = (j == 0) || (j == cur) || (j == cur - 1); sc[k] = !vj ? -INFINITY : (forced ? INFINITY : imp[k]); }
#pragma unroll
            for (int k = 0; k < 16; ++k) sp[k] = xor32(sc[k]);
            unsigned own = 0u;
#pragma unroll
            for (int k = 0; k < 16; ++k) { int rank = 0; const float me = sc[k];
#pragma unroll
                for (int q = 0; q < 16; ++q) { if (q < k) rank += (sc[q] >= me) ? 1 : 0; else if (q > k) rank += (sc[q] > me) ? 1 : 0;
                    if (q < k) rank += (sp[q] >= me) ? 1 : 0; else if (q > k) rank += (sp[q] > me) ? 1 : 0; else rank += (h ? (sp[q] >= me) : (sp[q] > me)) ? 1 : 0; }
                if (me > -INFINITY && rank < 16) own |= 1u << (2 * k + h); }
            rowmask = own | (unsigned)__shfl_xor((int)own, 32);
        }
        unsigned wm = rowmask; wm |= (unsigned)__shfl_xor((int)wm, 1); wm |= (unsigned)__shfl_xor((int)wm, 2); wm |= (unsigned)__shfl_xor((int)wm, 4);
        const unsigned wavemask = (unsigned)__builtin_amdgcn_readfirstlane((int)wm);
        if (lane == 0) atomicOr((unsigned*)UM, wavemask);
        __syncthreads();
        const unsigned umask = UM[0];
        {
            const bf16_t* kb = KSP + (size_t)bg * 2048 * 64; const bf16_t* vb = VSPT + (size_t)bg * 64 * 2048;
            float mrun = -1e30f, lrun = 0.f; f32x16 O[2];
#pragma unroll
            for (int db = 0; db < 2; ++db)
#pragma unroll
                for (int i = 0; i < 16; ++i) O[db][i] = 0.f;
            unsigned rem = umask; int buf = 0;
            int jc = rem ? __builtin_ctz(rem) : -1; if (jc >= 0) rem &= rem - 1;
            if (jc >= 0) { const TileRegs a = tile_load(kb + (size_t)jc * 64 * 64, vb + jc * 64, 2048, tid); tile_store(KT, VT, a, tid); }
            __syncthreads();
#pragma unroll 1
            while (jc >= 0) {
                const int jn = rem ? __builtin_ctz(rem) : -1; if (jn >= 0) rem &= rem - 1;
                TileRegs nx; if (jn >= 0) nx = tile_load(kb + (size_t)jn * 64 * 64, vb + jn * 64, 2048, tid);
                if ((wavemask >> jc) & 1u) attn_tile<1>(KT + buf * 64 * TS, VT + buf * 64 * TS, qf, r32, h, tq - 4 * h - 64 * jc, ((rowmask >> jc) & 1u) != 0u, slope2, mrun, lrun, O);
                if (jn >= 0) tile_store(KT + (buf ^ 1) * 64 * TS, VT + (buf ^ 1) * 64 * TS, nx, tid);
                __syncthreads();
                buf ^= 1; jc = jn;
            }
            const float inv = gt1 / fmaxf(lrun + xor32(lrun), 1e-30f);
#pragma unroll
            for (int db = 0; db < 2; ++db)
#pragma unroll
                for (int i = 0; i < 16; ++i) RES[64 * (db * 16 + i)] += inv * O[db][i];
        }
        {
            const bf16_t* kb = KWP + (size_t)bg * 2048 * 64; const bf16_t* vb = VWPT + (size_t)bg * 64 * 2048;
            float mrun = -1e30f, lrun = 0.f; f32x16 O[2];
#pragma unroll
            for (int db = 0; db < 2; ++db)
#pragma unroll
                for (int i = 0; i < 16; ++i) O[db][i] = 0.f;
            int jc = qt - 8 > 0 ? qt - 8 : 0, buf = 0;
            { const TileRegs a = tile_load(kb + (size_t)jc * 64 * 64, vb + jc * 64, 2048, tid); tile_store(KT, VT, a, tid); }
            __syncthreads();
#pragma unroll 1
            while (jc >= 0) {
                const int jn = jc < qt ? jc + 1 : -1;
                TileRegs nx; if (jn >= 0) nx = tile_load(kb + (size_t)jn * 64 * 64, vb + jn * 64, 2048, tid);
                attn_tile<2>(KT + buf * 64 * TS, VT + buf * 64 * TS, qf, r32, h, tq - 4 * h - 64 * jc, true, slope2, mrun, lrun, O);
                if (jn >= 0) tile_store(KT + (buf ^ 1) * 64 * TS, VT + (buf ^ 1) * 64 * TS, nx, tid);
                __syncthreads();
                buf ^= 1; jc = jn;
            }
            const float inv = gt2 / fmaxf(lrun + xor32(lrun), 1e-30f);
            bf16_t* orow = MIX + m * 2048 + 1024 + hd * 64 + 4 * h;
#pragma unroll
            for (int db = 0; db < 2; ++db)
#pragma unroll
                for (int q = 0; q < 4; ++q) { float y[4];
#pragma unroll
                    for (int e = 0; e < 4; ++e) y[e] = RES[64 * (db * 16 + 4 * q + e)] + inv * O[db][4 * q + e];
                    u32x2 w; w.x = cvt2(y[0], y[1]); w.y = cvt2(y[2], y[3]); *(u32x2*)(orow + db * 32 + 8 * q) = w; }
        }
    }
}

constexpr int CL2_WP = 264;
constexpr int CL2_LDS = 2 * 64 * CL2_WP * 2 + 2 * 256 * 4;
DI void cmp_l2_setup(const P& p, LAS unsigned char* tab, int tid) {
    LAS bf16_t* W2T = (LAS bf16_t*)tab; LAS float* BIAS = (LAS float*)(W2T + 2 * 64 * CL2_WP); const float* PEB = (const float*)(p.ws + CTL_PEB);
    __syncthreads();
    for (int i = tid; i < 2 * 256 * 64; i += 512) { const int c = i >> 14, hh = (i >> 6) & 255, d = i & 63; W2T[(c * 64 + d) * CL2_WP + hh] = (bf16_t)f2bf(p.cmp_w2[i]); }
    BIAS[tid] = PEB[tid] + p.cmp_b1[tid];
    __syncthreads();
}
template <int KB  > DI void cmp_l2_task(const P& p, const LAS unsigned char* tab, int c, int bg, int quarter, int lane) {
    const int r32 = lane & 31, h = lane >> 5; unsigned char* ws = p.ws; constexpr int WP = CL2_WP;
    const bf16_t* HPRE = (const bf16_t*)(ws + WS_HPRE); bf16_t *KC = (bf16_t*)(ws + WS_KC), *VC = (bf16_t*)(ws + WS_VC), *VCT = (bf16_t*)(ws + WS_VCT);
    const LAS bf16_t* W2T = (const LAS bf16_t*)tab; const LAS float* BIAS = (const LAS float*)(W2T + 2 * 64 * WP);
    {
        const int i0 = quarter * 32, i = i0 + r32;
        const size_t row = (size_t)bg * 128 + i;
        const bf16_t* h0 = HPRE + ((size_t)c * CM + row) * 512 + 8 * h; const bf16_t* h1 = h0 + 512 + 256;
        f32x16 O[2];
#pragma unroll
        for (int db = 0; db < 2; ++db)
#pragma unroll
            for (int q = 0; q < 16; ++q) O[db][q] = 0.f;
#pragma unroll 1
        for (int k0 = 0; k0 < 16; k0 += KB) {
        u32x4 ra[KB], rb[KB];
#pragma unroll
        for (int kq = 0; kq < KB; ++kq) { ra[kq] = *(const u32x4*)(h0 + (k0 + kq) * 16); rb[kq] = *(const u32x4*)(h1 + (k0 + kq) * 16); }
#pragma unroll
        for (int kq = 0; kq < KB; ++kq) { const int kk = k0 + kq;
            const unsigned aw[4] = {ra[kq].x, ra[kq].y, ra[kq].z, ra[kq].w}, bw[4] = {rb[kq].x, rb[kq].y, rb[kq].z, rb[kq].w};
            const LAS float* bs = BIAS + c * 256 + kk * 16 + 8 * h; const f32x4 b0 = *(const LAS f32x4*)bs, b1 = *(const LAS f32x4*)(bs + 4);
            float x[8];
#pragma unroll
            for (int j = 0; j < 8; ++j) { const unsigned wa = aw[j >> 1], wb = bw[j >> 1]; const float av = (j & 1) ? __uint_as_float(wa & 0xffff0000u) : __uint_as_float(wa << 16), bv = (j & 1) ? __uint_as_float(wb & 0xffff0000u) : __uint_as_float(wb << 16);
                x[j] = silu_f(av + bv + (j < 4 ? b0[j & 3] : b1[j & 3])); }
            u32x4 pk; pk.x = cvt2(x[0], x[1]); pk.y = cvt2(x[2], x[3]); pk.z = cvt2(x[4], x[5]); pk.w = cvt2(x[6], x[7]);
            const bf16x8 bf = __builtin_bit_cast(bf16x8, pk);
#pragma unroll
            for (int db = 0; db < 2; ++db) { const bf16x8 af = *(const LAS bf16x8*)(W2T + (c * 64 + db * 32 + r32) * WP + kk * 16 + 8 * h); O[db] = MFMA32(af, bf, O[db]); }
        }
        }
        float ss = 0.f;
#pragma unroll
        for (int db = 0; db < 2; ++db)
#pragma unroll
            for (int q = 0; q < 16; ++q) { const int d = 32 * db + (q & 3) + 8 * (q >> 2) + 4 * h; O[db][q] += p.cmp_b2[c * 64 + d]; ss += O[db][q] * O[db][q]; }
        ss += xor32(ss);
        const float r = (c == 0) ? rsqrtf(ss * (1.f / 64.f) + EPS) : 1.f; const bool live = i < 127;
#pragma unroll
        for (int db = 0; db < 2; ++db)
#pragma unroll
            for (int q4 = 0; q4 < 4; ++q4) { float y[4];
#pragma unroll
                for (int e = 0; e < 4; ++e) { const int d = 32 * db + e + 8 * q4 + 4 * h; float v = O[db][4 * q4 + e] * r; if (c == 0) v *= p.k_norm_cmp[d]; y[e] = live ? v : 0.f; }
                u32x2 w; w.x = cvt2(y[0], y[1]); w.y = cvt2(y[2], y[3]);
                *(u32x2*)((c ? VC : KC) + row * 64 + 32 * db + 8 * q4 + 4 * h) = w;
                if (c) {
#pragma unroll
                    for (int e = 0; e < 4; ++e) VCT[((size_t)bg * 64 + 32 * db + e + 8 * q4 + 4 * h) * 128 + i] = (bf16_t)(e & 1 ? (e == 1 ? w.x >> 16 : w.y >> 16) : (e == 0 ? w.x & 0xffffu : w.y & 0xffffu)); } }
    }
}
DI void phase_cmp_l2_mfma(const P& p, LAS unsigned char* lds, int bid, int G) {
    int tid = mk_tid(p.hi); const int lane = tid & 63, wave = tid >> 6;
    cmp_l2_setup(p, lds, tid);
#pragma unroll 1
    for (int task = bid * 8 + wave; task < 128; task += G * 8) cmp_l2_task<16>(p, lds, task >> 6, (task >> 2) & 15, task & 3, lane);
}

constexpr int VP = 40;
DI bf16x8 pack8f(const f32x4& a, const f32x4& b) { u32x4 p; p.x = cvt2(a.x, a.y); p.y = cvt2(a.z, a.w); p.z = cvt2(b.x, b.y); p.w = cvt2(b.z, b.w); return __builtin_bit_cast(bf16x8, p); }
DI void load_k32_f32(const float* kbase, int stride, int r32, int h, bf16x8 (&kf)[4]) {
    const float* kr = kbase + (size_t)r32 * stride + 8 * h;
#pragma unroll
    for (int kk = 0; kk < 4; ++kk) kf[kk] = pack8f(*(const f32x4*)(kr + 16 * kk), *(const f32x4*)(kr + 16 * kk + 4)); }
DI void stage_v32_f32(const float* vbase, int stride, LAS bf16_t* vt, int lane) {
    const int d4 = lane & 15, kg = lane >> 4;
#pragma unroll
    for (int it = 0; it < 2; ++it) { f32x4 v[4];
#pragma unroll
        for (int e = 0; e < 4; ++e) v[e] = *(const f32x4*)(vbase + (size_t)(16 * it + 4 * kg + e) * stride + 4 * d4);
#pragma unroll
        for (int dd = 0; dd < 4; ++dd) { u32x2 w; w.x = cvt2(v[0][dd], v[1][dd]); w.y = cvt2(v[2][dd], v[3][dd]); *(LAS u32x2*)(vt + (4 * d4 + dd) * VP + 16 * it + 4 * kg) = w; } }
}
DI void load_v32_lds(const LAS bf16_t* vt, int r32, int h, bf16x8 (&va)[2][2]) {
#pragma unroll
    for (int db = 0; db < 2; ++db)
#pragma unroll
        for (int s = 0; s < 2; ++s) { const LAS bf16_t* vr = vt + (db * 32 + r32) * VP + 16 * s + 4 * h; const s16x4 a0 = *(const LAS s16x4*)vr, a1 = *(const LAS s16x4*)(vr + 8); va[db][s] = __builtin_shufflevector(a0, a1, 0, 1, 2, 3, 4, 5, 6, 7); }
}

struct RawT { f32x4 k[8], v[8]; };
DI void raw_load(RawT& r, const float* kbase, const float* vbase, int stride, int r32, int h, int lane) {
    const float* kr = kbase + (size_t)r32 * stride + 8 * h; const int d4 = lane & 15, kg = lane >> 4;
#pragma unroll
    for (int kk = 0; kk < 4; ++kk) { r.k[2 * kk] = *(const f32x4*)(kr + 16 * kk); r.k[2 * kk + 1] = *(const f32x4*)(kr + 16 * kk + 4); }
#pragma unroll
    for (int it = 0; it < 2; ++it)
#pragma unroll
        for (int e = 0; e < 4; ++e) r.v[4 * it + e] = *(const f32x4*)(vbase + (size_t)(16 * it + 4 * kg + e) * stride + 4 * d4);
}
DI void raw_use(const RawT& r, LAS bf16_t* vt, int r32, int h, int lane, bf16x8 (&kf)[4], bf16x8 (&va)[2][2]) {
    const int d4 = lane & 15, kg = lane >> 4;
#pragma unroll
    for (int kk = 0; kk < 4; ++kk) kf[kk] = pack8f(r.k[2 * kk], r.k[2 * kk + 1]);
#pragma unroll
    for (int it = 0; it < 2; ++it)
#pragma unroll
        for (int dd = 0; dd < 4; ++dd) { u32x2 w; w.x = cvt2(r.v[4 * it][dd], r.v[4 * it + 1][dd]); w.y = cvt2(r.v[4 * it + 2][dd], r.v[4 * it + 3][dd]); *(LAS u32x2*)(vt + (4 * d4 + dd) * VP + 16 * it + 4 * kg) = w; }
    LDS_WAIT(); load_v32_lds(vt, r32, h, va);
}
template <int MODE> DI void attn_sub32(const bf16x8 (&kf)[4], const bf16x8 (&va)[2][2], const bf16x8 (&qf)[4], int d0, bool rowsel, float slope2, float& mrun, float& lrun, f32x16 (&O)[2]) {
    f32x16 S;
#pragma unroll
    for (int i = 0; i < 16; ++i) S[i] = 0.f;
#pragma unroll
    for (int kk = 0; kk < 4; ++kk) S = MFMA32(kf[kk], qf[kk], S);
    const float c1 = -slope2 * (float)d0; float tmax = -INFINITY;
#pragma unroll
    for (int i = 0; i < 16; ++i) { const int off = (i & 3) + 8 * (i >> 2); bool valid = rowsel && (off <= d0); if (MODE == 2) valid = valid && (d0 - off < 512);
        const float s2 = fmaf(S[i], LOG2E, fmaf(slope2, (float)off, c1)); S[i] = valid ? s2 : -INFINITY; tmax = fmaxf(tmax, S[i]); }
    tmax = fmaxf(tmax, xor32(tmax));
    const float mnew = fmaxf(mrun, tmax), alpha = __builtin_amdgcn_exp2f(mrun - mnew); mrun = mnew;
    float psum = 0.f;
#pragma unroll
    for (int i = 0; i < 16; ++i) { const float pr = __builtin_amdgcn_exp2f(S[i] - mnew); psum += pr; S[i] = pr; }
    lrun = lrun * alpha + psum;
#pragma unroll
    for (int db = 0; db < 2; ++db)
#pragma unroll
        for (int i = 0; i < 16; ++i) O[db][i] *= alpha;
    const bf16x8 p0 = pack_step<0>(S), p1 = pack_step<1>(S);
#pragma unroll
    for (int db = 0; db < 2; ++db) { O[db] = MFMA32(va[db][0], p0, O[db]); O[db] = MFMA32(va[db][1], p1, O[db]); }
}
DI void load_new_rows(const bf16_t* kbuf, const bf16_t* vbuf, size_t m0, int g, int r32, int h, bf16x8 (&kf)[4], bf16x8 (&va)[2][2]) {
#pragma unroll
    for (int kk = 0; kk < 4; ++kk) { u32x4 z = (u32x4){0u, 0u, 0u, 0u}; if (r32 < 8) z = *(const u32x4*)(kbuf + (m0 + r32) * 256 + g * 64 + 16 * kk + 8 * h); kf[kk] = __builtin_bit_cast(bf16x8, z); }
#pragma unroll
    for (int db = 0; db < 2; ++db) { bf16x8 a;
#pragma unroll
        for (int j = 0; j < 8; ++j) a[j] = 0;
#pragma unroll
        for (int j = 0; j < 4; ++j) a[j] = (short)vbuf[(m0 + 4 * h + j) * 256 + g * 64 + db * 32 + r32];
        va[db][0] = a;
#pragma unroll
        for (int j = 0; j < 8; ++j) a[j] = 0;
        va[db][1] = a; }
}

DI void phase_attn_sample(const P& p, LAS unsigned char* lds, int bid, int G) {
    const int wave = p.hi;
    unsigned char* ws = p.ws;
    const bf16_t *NQ = (const bf16_t*)(ws + WS_NQ), *KSLC = (const bf16_t*)(ws + WS_KSLC), *VSLC = (const bf16_t*)(ws + WS_VSLC), *KWIN = (const bf16_t*)(ws + WS_KWIN), *VWIN = (const bf16_t*)(ws + WS_VWIN);
    const bf16_t *KC = (const bf16_t*)(ws + WS_KC), *VCT = (const bf16_t*)(ws + WS_VCT); const float* GATES = (const float*)(ws + WS_GATES); bf16_t* MIX = (bf16_t*)(ws + WS_MIX);
    LAS bf16_t* vt = (LAS bf16_t*)lds + wave * 64 * VP;
    LAS float* XR = (LAS float*)(lds + 8 * 64 * VP * 2);
    LAS unsigned char* tab = lds + 61440;
    LAS float* PART0 = (LAS float*)(lds + 6 * 64 * VP * 2);
    LAS float* PART1 = (LAS float*)(lds + 61440 + CL2_LDS);
    LAS unsigned* MSK = (LAS unsigned*)(lds + 61440 + CL2_LDS + 34 * 64 * 4);
    static_assert(34 * 64 * 4 <= 2 * 64 * VP * 2 && 61440 + CL2_LDS + 34 * 64 * 4 + 2 * 34 * 4 <= LDS_MISC, "sample attention LDS map (3 waves per unit)");
    static_assert(8 * 64 * VP * 2 + 2 * 64 * 32 * 4 <= 61440 && 61440 + CL2_LDS <= LDS_MISC, "sample attention LDS map");
    static_assert(61440 + CL2_LDS + 34 * 64 * 4 + 2 * 34 * 4 <= 140288 && 140288 + 2 * 8448 <= LDS_MISC, "scratch of the two converting waves");
    { const int t0 = mk_tid(p.hi); if (t0 < 2) MSK[t0 * 34 + 33] = 0u; cmp_l2_setup(p, tab, t0); }
    const int ul = wave / 3, role = wave % 3;
    unsigned tag = 0u;
#pragma unroll 1
    for (int it = bid; it < 256; it += G) {
        const int lane = mk_tid(p.hi) & 63;
#pragma unroll 1
        for (int q = 0; q < 2; ++q) { const int t16 = wave + 8 * q, un = it * 2 + (t16 >> 3); cmp_l2_task<8>(p, tab, (t16 >> 2) & 1, (4 + (un >> 2)) * 4 + (un & 3), t16 & 3, lane); }
        asm volatile("s_waitcnt vmcnt(0)" ::: "memory"); __syncthreads();
        ++tag;
        if (wave >= 6) {
            LAS float* scr = (LAS float*)(lds + 140288 + (wave - 6) * 8448);
            ret_sample_wave(p, (LAS unsigned char*)scr, it * 2 + (wave - 6), lane);
            asm volatile("s_waitcnt vmcnt(0)" ::: "memory"); __syncthreads(); __syncthreads(); continue; }
        const int r32 = lane & 31, h = lane >> 5, ti = r32 & 7, rr = r32 >> 3;
        const int unit = it * 2 + ul, b = unit >> 2, g = unit & 3, hd = g * 4 + rr, qpos = 2048 + ti; const bool active = true;
        LAS float* part = (ul ? PART1 : PART0) + lane;
        const size_t m0 = (size_t)NP + b * 8, m = m0 + ti;
        f32x16 O[2]; float mrun = -1e30f, lrun = 0.f, gsel = 0.f;
        if (active) {
            bf16x8 qf[4];
#pragma unroll
            for (int kk = 0; kk < 4; ++kk) qf[kk] = *(const bf16x8*)(NQ + m * 1024 + hd * 64 + kk * 16 + h * 8);
            const float slope2 = exp2f(-0.5f * (float)(hd + 1)) * LOG2E;
#pragma unroll
            for (int db = 0; db < 2; ++db)
#pragma unroll
                for (int i = 0; i < 16; ++i) O[db][i] = 0.f;
            bf16x8 kf[4], va[2][2];
            if (role == 2) {
                const float gt2 = GATES[m * 48 + hd * 3 + 2];
                { const float* wb = p.cache_win + (size_t)b * 512 * 512 + g * 64; RawT ra;
                  raw_load(ra, wb, wb + 256, 512, r32, h, lane);
#pragma unroll 1
                  for (int s0 = 0; s0 < 512; s0 += 32) {
                      raw_use(ra, vt, r32, h, lane, kf, va);
                      if (s0 + 32 < 512) raw_load(ra, wb + (size_t)(s0 + 32) * 512, wb + (size_t)(s0 + 32) * 512 + 256, 512, r32, h, lane);
                      attn_sub32<2>(kf, va, qf, qpos - 4 * h - (1536 + s0), true, slope2, mrun, lrun, O); } }
                load_new_rows(KWIN, VWIN, m0, g, r32, h, kf, va);
                attn_sub32<2>(kf, va, qf, ti - 4 * h, true, slope2, mrun, lrun, O);
                const float inv = gt2 / fmaxf(lrun + xor32(lrun), 1e-30f);
#pragma unroll
                for (int db = 0; db < 2; ++db)
#pragma unroll
                    for (int q = 0; q < 4; ++q) *(LAS f32x4*)(XR + (ul * 64 + lane) * 32 + db * 16 + q * 4) = (f32x4){O[db][4 * q] * inv, O[db][4 * q + 1] * inv, O[db][4 * q + 2] * inv, O[db][4 * q + 3] * inv};
            } else {
                unsigned rowmask, rem; float gt1 = 0.f;
                volatile LAS unsigned* mk = MSK + ul * 34;
                if (role == 0) {
                const float gt0 = GATES[m * 48 + hd * 3 + 0]; gt1 = GATES[m * 48 + hd * 3 + 1]; const int bbg = (4 + b) * 4 + g;
                {
                    f32x16 S[4];
#pragma unroll
                    for (int s4 = 0; s4 < 4; ++s4) { f32x16 acc;
#pragma unroll
                        for (int i = 0; i < 16; ++i) acc[i] = 0.f;
#pragma unroll
                        for (int kk = 0; kk < 4; ++kk) { const bf16x8 a = *(const bf16x8*)(KC + ((size_t)bbg * 128 + s4 * 32 + r32) * 64 + kk * 16 + h * 8); acc = MFMA32(a, qf[kk], acc); }
                        S[s4] = acc; }
                    const int dq = qpos - 31 - 64 * h; const float c1 = -slope2 * (float)dq; float tmax = -INFINITY;
#pragma unroll
                    for (int s4 = 0; s4 < 4; ++s4)
#pragma unroll
                        for (int i = 0; i < 16; ++i) { const int off16 = 16 * (s4 * 32 + (i & 3) + 8 * (i >> 2));
                            const float s2 = fmaf(S[s4][i], LOG2E, fmaf(slope2, (float)off16, c1)); S[s4][i] = (off16 <= dq) ? s2 : -INFINITY; tmax = fmaxf(tmax, S[s4][i]); }
                    tmax = fmaxf(tmax, xor32(tmax));
                    const float mx = fmaxf(tmax, -1e30f); float psum = 0.f;
#pragma unroll
                    for (int s4 = 0; s4 < 4; ++s4)
#pragma unroll
                        for (int i = 0; i < 16; ++i) { const float pr = __builtin_amdgcn_exp2f(S[s4][i] - mx); psum += pr; S[s4][i] = pr; }
                    psum += xor32(psum);
                    const float invp = 1.f / fmaxf(psum, 1e-30f);
#pragma unroll
                    for (int s4 = 0; s4 < 4; ++s4)
#pragma unroll
                        for (int i = 0; i < 16; ++i) S[s4][i] *= invp;
#pragma unroll
                    for (int s4 = 0; s4 < 4; ++s4) { const bf16x8 p0 = pack_step<0>(S[s4]), p1 = pack_step<1>(S[s4]);
#pragma unroll
                        for (int db = 0; db < 2; ++db) { const bf16_t* vr = VCT + ((size_t)bbg * 64 + db * 32 + r32) * 128 + s4 * 32 + 4 * h;
                            const s16x4 a0 = *(const s16x4*)vr, a1 = *(const s16x4*)(vr + 8), b0 = *(const s16x4*)(vr + 16), b1 = *(const s16x4*)(vr + 24);
                            O[db] = MFMA32(__builtin_shufflevector(a0, a1, 0, 1, 2, 3, 4, 5, 6, 7), p0, O[db]); O[db] = MFMA32(__builtin_shufflevector(b0, b1, 0, 1, 2, 3, 4, 5, 6, 7), p1, O[db]); } }
#pragma unroll
                    for (int db = 0; db < 2; ++db)
#pragma unroll
                        for (int i = 0; i < 16; ++i) O[db][i] *= gt0;
                    { bf16_t* orow = MIX + m * 2048 + 1024 + hd * 64 + 4 * h;
#pragma unroll
                      for (int db = 0; db < 2; ++db)
#pragma unroll
                          for (int q = 0; q < 4; ++q) { u32x2 w; w.x = cvt2(O[db][4 * q], O[db][4 * q + 1]); w.y = cvt2(O[db][4 * q + 2], O[db][4 * q + 3]); *(u32x2*)(orow + db * 32 + 8 * q) = w; } }
#pragma unroll
                    for (int db = 0; db < 2; ++db)
#pragma unroll
                        for (int i = 0; i < 16; ++i) O[db][i] = 0.f;
                    float imp[16], tl[16];
#pragma unroll
                    for (int k = 0; k < 16; ++k) { const f32x16& T = S[k >> 2]; const int q = (k & 3) * 4; tl[k] = T[q + 3]; imp[k] = (T[q] + T[q + 1]) + (T[q + 2] + 0.5f * T[q + 3]); }
#pragma unroll
                    for (int k = 0; k < 16; ++k) tl[k] = xor32(tl[k]);
#pragma unroll
                    for (int k = 0; k < 16; ++k) { const float prev = h ? tl[k] : (k > 0 ? tl[k > 0 ? k - 1 : 0] : 0.f); float x = imp[k] + 0.5f * prev; x += __shfl_xor(x, 8); x += __shfl_xor(x, 16); imp[k] = x; }
                    float sc[16], sp[16];
#pragma unroll
                    for (int k = 0; k < 16; ++k) { const int j = 2 * k + h; sc[k] = (j == 0 || j == 31) ? INFINITY : imp[k]; }
#pragma unroll
                    for (int k = 0; k < 16; ++k) sp[k] = xor32(sc[k]);
                    unsigned own = 0u;
#pragma unroll
                    for (int k = 0; k < 16; ++k) { int rank = 0; const float me = sc[k];
#pragma unroll
                        for (int q = 0; q < 16; ++q) { if (q < k) rank += (sc[q] >= me) ? 1 : 0; else if (q > k) rank += (sc[q] > me) ? 1 : 0;
                            if (q < k) rank += (sp[q] >= me) ? 1 : 0; else if (q > k) rank += (sp[q] > me) ? 1 : 0; else rank += (h ? (sp[q] >= me) : (sp[q] > me)) ? 1 : 0; }
                        if (rank < 15) own |= 1u << (2 * k + h); }
                    rowmask = own | (unsigned)__shfl_xor((int)own, 32);
                }
                    unsigned wm = rowmask; wm |= (unsigned)__shfl_xor((int)wm, 1); wm |= (unsigned)__shfl_xor((int)wm, 2); wm |= (unsigned)__shfl_xor((int)wm, 4);
                    rem = (unsigned)__builtin_amdgcn_readfirstlane((int)wm);
                    if (lane < 32) mk[lane] = rowmask; if (lane == 0) mk[32] = rem; LDS_WAIT(); if (lane == 0) mk[33] = tag;
                } else {
                    while (mk[33] != tag) __builtin_amdgcn_s_sleep(2);
                    rowmask = mk[r32]; rem = (unsigned)__builtin_amdgcn_readfirstlane((int)mk[32]);
                }
                int j = -1;
                { int ord = 0; while (rem) { const int jj = __builtin_ctz(rem); rem &= rem - 1; if (((ord++) & 1) == role) { j = jj; break; } } if ((ord & 1) == 0 && j >= 0 && role == 0) {} }
                if (j >= 0) { RawT ra; int sub = 0;
                    const float* base = p.cache_kv + ((size_t)p.page_table[b * 16 + (j >> 1)] * 128 + (j & 1) * 64) * 1024 + g * 64;
                    raw_load(ra, base + 512, base + 768, 1024, r32, h, lane);
#pragma unroll 1
                    for (;;) { const bool rs = ((rowmask >> j) & 1u) != 0u; const int d0 = qpos - 4 * h - (64 * j + 32 * sub);
                        raw_use(ra, vt, r32, h, lane, kf, va);
                        bool more = true;
                        if (sub == 0) { sub = 1; base += 32 * 1024; }
                        else { if (rem) rem &= rem - 1;
                            if (rem) { j = __builtin_ctz(rem); rem &= rem - 1; sub = 0; base = p.cache_kv + ((size_t)p.page_table[b * 16 + (j >> 1)] * 128 + (j & 1) * 64) * 1024 + g * 64; } else more = false; }
                        if (more) raw_load(ra, base + 512, base + 768, 1024, r32, h, lane);
                        attn_sub32<1>(kf, va, qf, d0, rs, slope2, mrun, lrun, O);
                        if (!more) break; } }
                if (role == 0) {
                    load_new_rows(KSLC, VSLC, m0, g, r32, h, kf, va);
                    attn_sub32<1>(kf, va, qf, ti - 4 * h, true, slope2, mrun, lrun, O);
                    gsel = gt1;
                } else {
#pragma unroll
                    for (int db = 0; db < 2; ++db)
#pragma unroll
                        for (int i = 0; i < 16; ++i) part[64 * (db * 16 + i)] = O[db][i];
                    part[64 * 32] = mrun; part[64 * 33] = lrun;
                }
            }
        }
        asm volatile("s_waitcnt vmcnt(0)" ::: "memory"); __syncthreads();
        if (active && role == 0) {
            { const float mC = part[64 * 32], lC = part[64 * 33], M = fmaxf(mrun, mC), sA = __builtin_amdgcn_exp2f(mrun - M), sC = __builtin_amdgcn_exp2f(mC - M);
              const float lt = lrun * sA + lC * sC; const float inv = gsel / fmaxf(lt + xor32(lt), 1e-30f);
#pragma unroll
              for (int db = 0; db < 2; ++db)
#pragma unroll
                  for (int i = 0; i < 16; ++i) O[db][i] = inv * (O[db][i] * sA + part[64 * (db * 16 + i)] * sC); }
            bf16_t* orow = MIX + m * 2048 + 1024 + hd * 64 + 4 * h;
#pragma unroll
            for (int db = 0; db < 2; ++db)
#pragma unroll
                for (int q = 0; q < 4; ++q) { const f32x4 xb = *(const LAS f32x4*)(XR + (ul * 64 + lane) * 32 + db * 16 + q * 4);
                    const u32x2 cw = *(const u32x2*)(orow + db * 32 + 8 * q);
                    u32x2 w; w.x = cvt2(O[db][4 * q] + xb.x + __uint_as_float(cw.x << 16), O[db][4 * q + 1] + xb.y + __uint_as_float(cw.x & 0xffff0000u)); w.y = cvt2(O[db][4 * q + 2] + xb.z + __uint_as_float(cw.y << 16), O[db][4 * q + 3] + xb.w + __uint_as_float(cw.y & 0xffff0000u)); *(u32x2*)(orow + db * 32 + 8 * q) = w; }
        }
        __syncthreads();
    }
}

DI void phase_ret_kv_mfma(const P& p, int bid, int G) {
    int tid = mk_tid(p.hi); const int lane = tid & 63, wave = tid >> 6, r32 = lane & 31, h = lane >> 5; unsigned char* ws = p.ws;
    const bf16_t *RKT = (const bf16_t*)(ws + WS_RKT), *RVT = (const bf16_t*)(ws + WS_RVT); float* KVT = (float*)(ws + WS_KVT);
    const int e0 = 64 * (wave >> 1);
#pragma unroll 1
    for (int it = bid * 2; it < 512; it += G * 2) {
#pragma unroll 1
      for (int dq = 0; dq < 2; ++dq) {
        const int unit = it >> 1, d0 = 128 * (wave & 1) + 64 * dq, bh = unit >> 4, c = unit & 15;
        const bf16_t* va = RVT + ((size_t)bh * 256 + e0 + r32) * 2048 + c * 128 + 8 * h; const bf16_t* kb = RKT + ((size_t)bh * 256 + d0 + r32) * 2048 + c * 128 + 8 * h;
        f32x16 acc[2][2];
#pragma unroll
        for (int a = 0; a < 2; ++a)
#pragma unroll
            for (int q = 0; q < 2; ++q)
#pragma unroll
                for (int i = 0; i < 16; ++i) acc[a][q][i] = 0.f;
#pragma unroll
        for (int s = 0; s < 8; ++s) { bf16x8 af[2], bf[2];
#pragma unroll
            for (int a = 0; a < 2; ++a) af[a] = *(const bf16x8*)(va + (size_t)a * 32 * 2048 + s * 16);
#pragma unroll
            for (int q = 0; q < 2; ++q) bf[q] = *(const bf16x8*)(kb + (size_t)q * 32 * 2048 + s * 16);
#pragma unroll
            for (int a = 0; a < 2; ++a)
#pragma unroll
                for (int q = 0; q < 2; ++q) acc[a][q] = MFMA32(af[a], bf[q], acc[a][q]); }
#pragma unroll
        for (int a = 0; a < 2; ++a)
#pragma unroll
            for (int q = 0; q < 2; ++q) { float* o = KVT + (size_t)unit * 65536 + (size_t)(e0 + 32 * a + 4 * h) * 256 + d0 + 32 * q + r32;
#pragma unroll
                for (int i = 0; i < 16; ++i) o[((i & 3) + 8 * (i >> 2)) * 256] = acc[a][q][i];
                asm volatile("" ::: "memory"); }
      }
    }
}
DI void phase_ret_scan_t(const P& p, int bid, int G) {
    int tid = mk_tid(p.hi); unsigned char* ws = p.ws;
    const float* KVT = (const float*)(ws + WS_KVT); bf16_t* SSTT = (bf16_t*)(ws + WS_SSTT);
    for (int i = bid * 512 + tid; i < 16 * 16384; i += G * 512) {
        const int bh = i >> 14, q = (i & 16383) * 4, e = q >> 8, d = q & 255; const float gc = exp2f(gamma_log2(bh & 3) * 128.f);
        f32x4 S = (f32x4){0.f, 0.f, 0.f, 0.f}, kv[16];
#pragma unroll
        for (int c = 0; c < 16; ++c) kv[c] = *(const f32x4*)(KVT + ((size_t)bh * 16 + c) * 65536 + q);
#pragma unroll
        for (int c = 0; c < 16; ++c) { *(u32x2*)(SSTT + ((size_t)bh * 16 + c) * 65536 + q) = (u32x2){cvt2(S[0], S[1]), cvt2(S[2], S[3])}; S = (S + kv[c]) * gc; }
        float* o = p.out + O_RETP + (size_t)bh * 65536 + e;
#pragma unroll
        for (int k = 0; k < 4; ++k) o[(size_t)(d + k) * 256] = S[k];
    }
}
DI void phase_ret_out_mfma(const P& p, LAS unsigned char* lds, int bid, int G) {
    int tid = mk_tid(p.hi); const int lane = tid & 63, wave = tid >> 6, r32 = lane & 31, h = lane >> 5, tq = wave & 3, eh = wave >> 2; unsigned char* ws = p.ws;
    const bf16_t *RQ = (const bf16_t*)(ws + WS_RQ), *RK = (const bf16_t*)(ws + WS_RK), *RVT = (const bf16_t*)(ws + WS_RVT), *SSTT = (const bf16_t*)(ws + WS_SSTT), *RGS = (const bf16_t*)(ws + WS_RGS);
    bf16_t* MIX = (bf16_t*)(ws + WS_MIX); LAS float* SS = (LAS float*)lds;
#pragma unroll 1
    for (int unit = bid; unit < 256; unit += G) {
        const int bh = unit >> 4, b = bh >> 2, hh = bh & 3, c = unit & 15; const size_t m0 = (size_t)b * 2048 + c * 128;
        bf16x8 qf[16];
#pragma unroll
        for (int s = 0; s < 16; ++s) qf[s] = *(const bf16x8*)(RQ + (m0 + 32 * tq + r32) * 1024 + hh * 256 + 16 * s + 8 * h);
        f32x16 O[4];
#pragma unroll
        for (int eb = 0; eb < 4; ++eb)
#pragma unroll
            for (int i = 0; i < 16; ++i) O[eb][i] = 0.f;
        const bf16_t* vt = RVT + ((size_t)bh * 256 + 128 * eh + r32) * 2048 + c * 128 + 4 * h;
#pragma unroll 1
        for (int jb = 0; jb <= tq; ++jb) {
            f32x16 S;
#pragma unroll
            for (int i = 0; i < 16; ++i) S[i] = 0.f;
            const bf16_t* kr = RK + (m0 + 32 * jb + r32) * 1024 + hh * 256 + 8 * h;
            s16x4 vf[4][4];
#pragma unroll
            for (int eb = 0; eb < 4; ++eb) { const bf16_t* vr = vt + (size_t)eb * 32 * 2048 + 32 * jb;
#pragma unroll
                for (int q = 0; q < 4; ++q) vf[eb][q] = *(const s16x4*)(vr + 8 * q); }
            bf16x8 kfr[16];
#pragma unroll
            for (int s = 0; s < 16; ++s) kfr[s] = *(const bf16x8*)(kr + 16 * s);
            asm volatile("" ::: "memory");
#pragma unroll
            for (int s = 0; s < 16; ++s) S = MFMA32(kfr[s], qf[s], S);
            if (jb == tq) {
#pragma unroll
                for (int i = 0; i < 16; ++i) if ((i & 3) + 8 * (i >> 2) + 4 * h > r32) S[i] = 0.f;
            }
            const bf16x8 p0 = pack_step<0>(S), p1 = pack_step<1>(S);
#pragma unroll
            for (int eb = 0; eb < 4; ++eb) { const s16x4 a0 = vf[eb][0], a1 = vf[eb][1], b0 = vf[eb][2], b1 = vf[eb][3];
                O[eb] = MFMA32(__builtin_shufflevector(a0, a1, 0, 1, 2, 3, 4, 5, 6, 7), p0, O[eb]); O[eb] = MFMA32(__builtin_shufflevector(b0, b1, 0, 1, 2, 3, 4, 5, 6, 7), p1, O[eb]); }
        }
        { const bf16_t* st = SSTT + (size_t)unit * 65536 + (size_t)(128 * eh + r32) * 256 + 8 * h;
#pragma unroll
          for (int s0 = 0; s0 < 16; s0 += 4) { bf16x8 sf[4][4];
#pragma unroll
              for (int j = 0; j < 4; ++j)
#pragma unroll
                  for (int eb = 0; eb < 4; ++eb) sf[j][eb] = *(const bf16x8*)(st + (size_t)eb * 32 * 256 + 16 * (s0 + j));
              asm volatile("" ::: "memory");
#pragma unroll
              for (int j = 0; j < 4; ++j)
#pragma unroll
                  for (int eb = 0; eb < 4; ++eb) O[eb] = MFMA32(sf[j][eb], qf[s0 + j], O[eb]); } }
        float ss = 0.f;
#pragma unroll
        for (int eb = 0; eb < 4; ++eb)
#pragma unroll
            for (int i = 0; i < 16; ++i) ss += O[eb][i] * O[eb][i];
        ss += xor32(ss);
        __syncthreads();
        if (h == 0) SS[(eh * 4 + tq) * 32 + r32] = ss;
        __syncthreads();
        const float r = rsqrtf((SS[tq * 32 + r32] + SS[(4 + tq) * 32 + r32]) * (1.f / 256.f) + EPS);
        const size_t m = m0 + 32 * tq + r32; const int ec = hh * 256 + 128 * eh + 4 * h;
#pragma unroll
        for (int eb = 0; eb < 4; ++eb)
#pragma unroll
            for (int q4 = 0; q4 < 4; ++q4) { const int e = ec + 32 * eb + 8 * q4; const u32x2 rgb = *(const u32x2*)(RGS + m * 1024 + e); const f32x4 gn = *(const f32x4*)(p.ret_gn + e);
                u32x2 w; w.x = cvt2(O[eb][4 * q4] * r * gn[0] * __uint_as_float(rgb.x << 16), O[eb][4 * q4 + 1] * r * gn[1] * __uint_as_float(rgb.x & 0xffff0000u));
                w.y = cvt2(O[eb][4 * q4 + 2] * r * gn[2] * __uint_as_float(rgb.y << 16), O[eb][4 * q4 + 3] * r * gn[3] * __uint_as_float(rgb.y & 0xffff0000u));
                *(u32x2*)(MIX + m * 2048 + e) = w; }
    }
}


typedef pg8::Unit Unit;
#define EPI_ARGS const f32x4 (&acc)[2][2][4][2], const Unit& u, int wr, int wc, int fr, int fq
struct EpiZ { static constexpr bool PERM = false, AFTER_DRAIN = false; float* Zp; const float* rstd;
    DI void operator()(EPI_ARGS) const {
        const int row0 = u.pm * 256 + wr * 64 + fr, col0 = u.pn * 256 + wc * 32 + 4 * fq;
#pragma unroll
        for (int ai = 0; ai < 2; ++ai)
#pragma unroll
            for (int m = 0; m < 4; ++m) { const int r = row0 + ai * 128 + m * 16; const float s = rstd[r]; float* rowp = Zp + (size_t)r * DINP + col0;
#pragma unroll
                for (int bj = 0; bj < 2; ++bj)
#pragma unroll
                    for (int n = 0; n < 2; ++n) *(f32x4*)(rowp + bj * 128 + n * 16) = acc[ai][bj][m][n] * s; }
    } };

DI u32x2 pk4(const f32x4& v) { u32x2 w; w.x = pg8::cvt_pk_bf16(v[0], v[1]); w.y = pg8::cvt_pk_bf16(v[2], v[3]); return w; }
DI u32x4 pk8(const float (&y)[8]) { u32x4 w; w.x = pg8::cvt_pk_bf16(y[0], y[1]); w.y = pg8::cvt_pk_bf16(y[2], y[3]); w.z = pg8::cvt_pk_bf16(y[4], y[5]); w.w = pg8::cvt_pk_bf16(y[6], y[7]); return w; }
struct EpiProj { static constexpr bool PERM = false, AFTER_DRAIN = false;
    const float* rstd; const float* SCf; float* out; unsigned char* ws;
    DI void operator()(const f32x4 (&acc)[2][2][4][2], const pg8::Unit2& u, int wr, int wc, int fr0, int fq0) const {
        int fr = fr0, fq = fq0; asm volatile("" : "+v"(fr), "+v"(fq));
        const int pn = u.pn, tok0 = u.pm * 256 + wr * 128 + fr * 8; const bool prompt = u.pm < 32;
        const int b = prompt ? (tok0 >> 11) : ((tok0 - NP) >> 3), t0 = prompt ? (tok0 & 2047) : 0;
        float rs[8];
#pragma unroll
        for (int j = 0; j < 8; ++j) rs[j] = rstd[tok0 + j];
        if (pn < 8) {
            const int hh = pn & 3; const bool isk = pn >= 4; const float lg = log2f(1.f - exp2f(-5.f - (float)hh)) * (isk ? -1.f : 1.f);
            bf16_t* dst = (bf16_t*)(ws + (isk ? WS_RK : WS_RQ)) + hh * 256 + wc * 32 + 4 * fq; const int ic0 = prompt ? (t0 & 127) : 0, pos0 = prompt ? t0 : 2048;
#pragma unroll
            for (int j = 0; j < 8; ++j) rs[j] *= exp2f(lg * (float)(ic0 + j + 1)) * (isk ? 0.0625f : 1.f);
#pragma unroll
            for (int n = 0; n < 2; ++n) {
                float y1[4][8], y2[4][8];
#pragma unroll
                for (int j = 0; j < 8; ++j) { const float* scp = SCf + ((size_t)(pos0 + j) * 128 + wc * 32 + n * 16 + 4 * fq) * 2; const f32x4 ca = *(const f32x4*)scp, cb = *(const f32x4*)(scp + 4);
                    const f32x4 x1 = acc[j >> 2][0][j & 3][n] * rs[j], x2 = acc[j >> 2][1][j & 3][n] * rs[j];
                    y1[0][j] = x1[0] * ca[0] - x2[0] * ca[1]; y1[1][j] = x1[1] * ca[2] - x2[1] * ca[3]; y1[2][j] = x1[2] * cb[0] - x2[2] * cb[1]; y1[3][j] = x1[3] * cb[2] - x2[3] * cb[3];
                    y2[0][j] = x2[0] * ca[0] + x1[0] * ca[1]; y2[1][j] = x2[1] * ca[2] + x1[1] * ca[3]; y2[2][j] = x2[2] * cb[0] + x1[2] * cb[1]; y2[3][j] = x2[3] * cb[2] + x1[3] * cb[3];
                    *(u32x2*)(dst + (size_t)(tok0 + j) * 1024 + n * 16) = pk4((f32x4){y1[0][j], y1[1][j], y1[2][j], y1[3][j]});
                    *(u32x2*)(dst + (size_t)(tok0 + j) * 1024 + 128 + n * 16) = pk4((f32x4){y2[0][j], y2[1][j], y2[2][j], y2[3][j]}); }
                if (isk && prompt) {
                    bf16_t* dt = (bf16_t*)(ws + WS_RKT) + ((size_t)(b * 4 + hh) * 256 + wc * 32 + n * 16 + 4 * fq) * 2048 + t0;
#pragma unroll
                    for (int e = 0; e < 4; ++e) { *(u32x4*)(dt + (size_t)e * 2048) = pk8(y1[e]); *(u32x4*)(dt + (size_t)(128 + e) * 2048) = pk8(y2[e]); } }
                asm volatile("" ::: "memory");
            }
        } else if (pn < 16) {
            const int hh = pn & 3; const bool gate = pn >= 12;
            bf16_t* dst = (bf16_t*)(ws + (gate ? WS_RGS : WS_RV)) + hh * 256 + wc * 32 + 4 * fq;
            if (gate || !prompt)
#pragma unroll
            for (int j = 0; j < 8; ++j)
#pragma unroll
                for (int bj = 0; bj < 2; ++bj)
#pragma unroll
                    for (int n = 0; n < 2; ++n) { f32x4 v = acc[j >> 2][bj][j & 3][n] * rs[j]; if (gate) v = (f32x4){silu_f(v[0]), silu_f(v[1]), silu_f(v[2]), silu_f(v[3])};
                        *(u32x2*)(dst + (size_t)(tok0 + j) * 1024 + bj * 128 + n * 16) = pk4(v); }
            if (!gate && prompt) {
                const int fqo = fq;
                bf16_t* dt = (bf16_t*)(ws + WS_RVT) + ((size_t)(b * 4 + hh) * 256 + wc * 32 + 4 * fqo) * 2048 + t0;
#pragma unroll
                for (int bj = 0; bj < 2; ++bj)
#pragma unroll
                    for (int n = 0; n < 2; ++n)
#pragma unroll
                        for (int e = 0; e < 4; ++e) { float y[8];
#pragma unroll
                            for (int j = 0; j < 8; ++j) y[j] = acc[j >> 2][bj][j & 3][n][e] * rs[j];
                            *(u32x4*)(dt + (size_t)(bj * 128 + n * 16 + e) * 2048) = pk8(y); asm volatile("" ::: "memory"); } }
        } else if (pn < 26) {
            const int slot = pn - 20; const bool norm = slot < 0 || slot == 2 || slot == 4; const float* gvec = (const float*)(ws + WS_NORMS) + (slot < 0 ? 0 : (slot >> 1) * 64);
            f32x4 gv[2][2];
#pragma unroll
            for (int bj = 0; bj < 2; ++bj)
#pragma unroll
                for (int n = 0; n < 2; ++n) gv[bj][n] = norm ? *(const f32x4*)(gvec + 32 * bj + 16 * n + 4 * fq) : (f32x4){1.f, 1.f, 1.f, 1.f};
            bf16_t *NQ = (bf16_t*)(ws + WS_NQ), *CBU = (bf16_t*)(ws + WS_CBU);
            const int s2i = slot >= 2 ? slot - 2 : 0;
            bf16_t* tokb = (bf16_t*)(ws + WS_KSLC + (size_t)s2i * ((size_t)MT * 512));
            bf16_t* seqb = (bf16_t*)(ws + WS_KSP + (size_t)s2i * 4194304);
#pragma unroll
            for (int j = 0; j < 8; ++j) { const int r = tok0 + j, t = prompt ? t0 + j : j;
                f32x4 v[2][2]; float ss = 0.f;
#pragma unroll
                for (int bj = 0; bj < 2; ++bj)
#pragma unroll
                    for (int n = 0; n < 2; ++n) { v[bj][n] = acc[j >> 2][bj][j & 3][n] * rs[j]; ss += (v[bj][n][0] * v[bj][n][0] + v[bj][n][1] * v[bj][n][1]) + (v[bj][n][2] * v[bj][n][2] + v[bj][n][3] * v[bj][n][3]); }
                if (norm) { ss += __shfl_xor(ss, 16); ss += __shfl_xor(ss, 32); const float rn = rsqrtf(ss * (1.f / 64.f) + EPS) * (slot < 0 ? 0.125f : 1.f);
#pragma unroll
                    for (int bj = 0; bj < 2; ++bj)
#pragma unroll
                        for (int n = 0; n < 2; ++n) v[bj][n] = v[bj][n] * rn * gv[bj][n]; }
#pragma unroll
                for (int bj = 0; bj < 2; ++bj)
#pragma unroll
                    for (int n = 0; n < 2; ++n) { const int d = 32 * bj + 16 * n + 4 * fq; const f32x4 x = v[bj][n]; const u32x2 xb = pk4(x);
                        if (slot < 0) { *(u32x2*)(NQ + (size_t)r * 1024 + ((pn - 16) * 4 + wc) * 64 + d) = xb; continue; }
                        if (slot < 4) *(f32x4*)(out + O_KV + (size_t)r * 1024 + slot * 256 + wc * 64 + d) = x;
                        if (slot < 2) { if (prompt) *(u32x2*)(CBU + ((((size_t)slot * NBB + b) * 4 + wc) * 2048 + t) * 64 + d) = xb; continue; }
                        if (!prompt) *(u32x2*)(tokb + (size_t)r * 256 + wc * 64 + d) = xb;
                        if (prompt && (slot == 2 || slot == 4)) *(u32x2*)(seqb + (((size_t)b * 4 + wc) * 2048 + t) * 64 + d) = xb;
                        if (slot >= 4) { if (prompt) { if (t >= 1536) *(f32x4*)(out + O_WINP + (((size_t)b * 512 + (t - 1536)) * 2 + (slot - 4)) * 256 + wc * 64 + d) = x; }
                            else *(f32x4*)(out + O_WINS + (((size_t)b * 512 + 504 + t) * 2 + (slot - 4)) * 256 + wc * 64 + d) = x; } } }
            if (prompt && (slot == 3 || slot == 5)) {
                const int fqo = fq;
                bf16_t* dt = seqb + (((size_t)b * 4 + wc) * 64 + 4 * fqo) * 2048 + t0;
#pragma unroll
                for (int bj = 0; bj < 2; ++bj)
#pragma unroll
                    for (int n = 0; n < 2; ++n)
#pragma unroll
                        for (int e = 0; e < 4; ++e) { float y[8];
#pragma unroll
                            for (int j = 0; j < 8; ++j) y[j] = acc[j >> 2][bj][j & 3][n][e] * rs[j];
                            *(u32x4*)(dt + (size_t)(32 * bj + 16 * n + e) * 2048) = pk8(y); asm volatile("" ::: "memory"); } }
        } else {
            float* GATES = (float*)(ws + WS_GATES);
#pragma unroll
            for (int j = 0; j < 8; ++j)
#pragma unroll
                for (int n = 0; n < 2; ++n) { const int c = wc * 32 + n * 16 + 4 * fq; if (c < 48) { const f32x4 v = acc[j >> 2][0][j & 3][n] * rs[j]; *(f32x4*)(GATES + (size_t)(tok0 + j) * 48 + c) = (f32x4){sigmoid_f(v[0]), sigmoid_f(v[1]), sigmoid_f(v[2]), sigmoid_f(v[3])}; } }
        }
    } };
struct ProjOrder { int G, c, i0, i1;
    DI bool next(int i, pg8::Unit2& u) const { if (i0 + i >= i1) return false; pg8::StaticOrder so; so.init(MT, DINP, G, c); pg8::Unit t; if (!so.next(i0 + i, t)) return false; u.pm = t.pm; u.pn = t.pn; u.kt0 = 0; u.nt = D / 64; return true; }
};
struct EpiHpre { static constexpr bool PERM = true, AFTER_DRAIN = false; bf16_t* Hp;
    DI void operator()(EPI_ARGS) const {
        const int row0 = u.pm * 256 + wr * 64 + fr, col0 = (u.pn & 1) * 256 + wc * 32 + 8 * fq;
#pragma unroll
        for (int ai = 0; ai < 2; ++ai)
#pragma unroll
            for (int m = 0; m < 4; ++m) { bf16_t* rowp = Hp + (size_t)(row0 + ai * 128 + m * 16) * 512 + col0;
#pragma unroll
                for (int bj = 0; bj < 2; ++bj) { const f32x4 v0 = acc[ai][bj][m][0], v1 = acc[ai][bj][m][1]; u32x4 w;
                    w.x = pg8::cvt_pk_bf16(v0[0], v0[1]); w.y = pg8::cvt_pk_bf16(v0[2], v0[3]); w.z = pg8::cvt_pk_bf16(v1[0], v1[1]); w.w = pg8::cvt_pk_bf16(v1[2], v1[3]);
                    *(u32x4*)(rowp + bj * 128) = w; } }
    } };
struct EpiOut { static constexpr bool PERM = false, AFTER_DRAIN = false; const float *xp, *xs, *gf; float* H; bf16_t* HG; float* rowss; float* SLAB;
    DI void operator()(const f32x4 (&acc)[2][2][4][2], const pg8::Unit2& u, int wr, int wc, int fr, int fq) const {
        const int row0 = u.pm * 256 + wr * 64 + fr, col0 = u.pn * 256 + wc * 32 + 4 * fq;
        if (u.nt != D / 64) {
#pragma unroll
            for (int ai = 0; ai < 2; ++ai)
#pragma unroll
                for (int m = 0; m < 4; ++m) { float* sp = SLAB + (size_t)(u.kt0 / 4) * NS * D + (size_t)(row0 + ai * 128 + m * 16 - NP) * D + col0;
#pragma unroll
                    for (int bj = 0; bj < 2; ++bj)
#pragma unroll
                        for (int n = 0; n < 2; ++n) *(f32x4*)(sp + bj * 128 + n * 16) = acc[ai][bj][m][n]; }
            return; }
        f32x4 gv[2][2];
#pragma unroll
        for (int bj = 0; bj < 2; ++bj)
#pragma unroll
            for (int n = 0; n < 2; ++n) gv[bj][n] = *(const f32x4*)(gf + col0 + bj * 128 + n * 16);
#pragma unroll
        for (int ai = 0; ai < 2; ++ai)
#pragma unroll
            for (int m = 0; m < 4; ++m) { const int r = row0 + ai * 128 + m * 16; const float* xr = (r < NP ? xp + (size_t)r * D : xs + (size_t)(r - NP) * D) + col0; float ss = 0.f;
#pragma unroll
                for (int bj = 0; bj < 2; ++bj)
#pragma unroll
                    for (int n = 0; n < 2; ++n) { const f32x4 h = *(const f32x4*)(xr + bj * 128 + n * 16) + acc[ai][bj][m][n];
                        *(f32x4*)(H + (size_t)r * D + col0 + bj * 128 + n * 16) = h; ss += (h[0] * h[0] + h[1] * h[1]) + (h[2] * h[2] + h[3] * h[3]);
                        const f32x4 hg = h * gv[bj][n]; u32x2 w; w.x = pg8::cvt_pk_bf16(hg[0], hg[1]); w.y = pg8::cvt_pk_bf16(hg[2], hg[3]);
                        *(u32x2*)(HG + (size_t)r * D + col0 + bj * 128 + n * 16) = w; }
                ss += __shfl_xor(ss, 16); ss += __shfl_xor(ss, 32);
                if (fq == 0) atomicAdd(rowss + r, ss); }
    } };
struct OutOrder { int G, c;
    DI bool next(int i, pg8::Unit2& u) const { const long L = (long)i * G + c;
        if (L < 256) { pg8::StaticOrder so; so.init(NP, D, 1, (int)L); pg8::Unit t; so.next(0, t); u.pm = t.pm; u.pn = t.pn; u.kt0 = 0; u.nt = D / 64; return true; }
        if (L < 512) { const int q = (int)L - 256, tile = q >> 3, ks = q & 7; u.pm = 32 + (tile >> 3); u.pn = tile & 7; u.kt0 = ks * 4; u.nt = 4; return true; }
        return false; }
};
DI void phase_out_reduce(const P& p, int bid, int G) {
    int tid = mk_tid(p.hi); const int lane = tid & 63, wave = tid >> 6; unsigned char* ws = p.ws;
    const float* SL = (const float*)(ws + WS_SLAB); float* H = (float*)(ws + WS_H); bf16_t* HG = (bf16_t*)(ws + WS_HG); float* rowss = (float*)(ws + CTL_ROWSS);
    for (int it = bid * 8 + wave; it < NS * 2; it += G * 8) { const int r = it >> 1, j0 = (it & 1) * 4; float ss = 0.f;
#pragma unroll
        for (int j = j0; j < j0 + 4; ++j) { const size_t o = (size_t)r * D + (j * 64 + lane) * 4;
            f32x4 h = *(const f32x4*)(p.x_sample + o);
#pragma unroll
            for (int k = 0; k < 8; ++k) h += *(const f32x4*)(SL + (size_t)k * NS * D + o);
            *(f32x4*)(H + (size_t)NP * D + o) = h; ss += (h[0] * h[0] + h[1] * h[1]) + (h[2] * h[2] + h[3] * h[3]);
            const f32x4 hg = h * *(const f32x4*)(p.g_ffn + (j * 64 + lane) * 4); u32x2 w; w.x = pg8::cvt_pk_bf16(hg[0], hg[1]); w.y = pg8::cvt_pk_bf16(hg[2], hg[3]);
            *(u32x2*)(HG + (size_t)NP * D + o) = w; }
        ss = wave_sum(ss); if (lane == 0) atomicAdd(rowss + NP + r, ss); }
}
struct EpiUp { static constexpr bool PERM = true, AFTER_DRAIN = false; bf16_t* U; const float* rowss; float* out;
    DI void operator()(EPI_ARGS) const {
        const int row0 = u.pm * 256 + wr * 64 + fr, col0 = u.pn * 256 + wc * 32 + 8 * fq;
#pragma unroll
        for (int ai = 0; ai < 2; ++ai)
#pragma unroll
            for (int m = 0; m < 4; ++m) { const int r = row0 + ai * 128 + m * 16; const float s = rsqrtf(rowss[r] * (1.f / D) + EPS);
                float* cs = nullptr;
                if (r < NP) { const int t = r & 2047; if (t >= 2046) cs = out + O_CONVP + ((size_t)(r >> 11) * 2 + (t - 2046)) * FF2; }
                else { const int t = (r - NP) & 7; if (t >= 6) cs = out + O_CONVS + ((size_t)((r - NP) >> 3) * 2 + (t - 6)) * FF2; }
#pragma unroll
                for (int bj = 0; bj < 2; ++bj) { const f32x4 v0 = acc[ai][bj][m][0] * s, v1 = acc[ai][bj][m][1] * s; u32x4 w;
                    w.x = pg8::cvt_pk_bf16(v0[0], v0[1]); w.y = pg8::cvt_pk_bf16(v0[2], v0[3]); w.z = pg8::cvt_pk_bf16(v1[0], v1[1]); w.w = pg8::cvt_pk_bf16(v1[2], v1[3]);
                    *(u32x4*)(U + (size_t)r * FF2 + col0 + bj * 128) = w;
                    if (cs) { *(f32x4*)(cs + col0 + bj * 128) = v0; *(f32x4*)(cs + col0 + bj * 128 + 4) = v1; } } }
    } };

DI f32x4 dpp_shr1(const f32x4& v) { f32x4 r;
#pragma unroll
    for (int e = 0; e < 4; ++e) r[e] = __int_as_float(__builtin_amdgcn_update_dpp(0, __float_as_int(v[e]), 0x111, 0xf, 0xf, false));
    return r; }
DI f32x4 silu4(const f32x4& v) { return (f32x4){silu_f(v[0]), silu_f(v[1]), silu_f(v[2]), silu_f(v[3])}; }
struct EpiUpConv { static constexpr bool PERM = false, AFTER_DRAIN = false; bf16_t* ACT; const float* rowss; const float *conv_w, *conv_b, *state_conv; float* out; float* UX;
    DI void operator()(const f32x4 (&acc)[2][2][4][2], const pg8::Unit2& u, int wr, int wc, int fr, int fq) const {
        const bool prompt = u.pm < 32; const int tok0 = u.pm * 256 + wr * 128 + fr * 8;
        float rs[8];
#pragma unroll
        for (int j = 0; j < 8; ++j) rs[j] = rsqrtf(rowss[tok0 + j] * (1.f / D) + EPS);
        const int sb = (tok0 - NP) >> 3;
        const bool cstate = prompt ? ((u.pm & 7) == 7 && wr == 1 && fr == 15) : true;
        float* cso = prompt ? out + O_CONVP + (size_t)(u.pm >> 3) * 2 * FF2 : out + O_CONVS + (size_t)sb * 2 * FF2;
#pragma unroll
        for (int n = 0; n < 2; ++n) {
            const int q = wc * 32 + n * 16 + fq * 4, ca = u.pn * 128 + q;
            f32x4 cv[8];
#pragma unroll
            for (int hf = 0; hf < 2; ++hf) {
                const int col = ca + hf * FF;
                const f32x4 w0 = *(const f32x4*)(conv_w + col), w1 = *(const f32x4*)(conv_w + FF2 + col), w2 = *(const f32x4*)(conv_w + 2 * FF2 + col), cb = *(const f32x4*)(conv_b + col);
                f32x4 uu[8];
#pragma unroll
                for (int j = 0; j < 8; ++j) uu[j] = acc[j >> 2][hf][j & 3][n] * rs[j];
                f32x4 p1, p2;
                if (prompt) { p1 = dpp_shr1(uu[7]); p2 = dpp_shr1(uu[6]); }
                else { p1 = *(const f32x4*)(state_conv + ((size_t)sb * 2 + 1) * FF2 + col); p2 = *(const f32x4*)(state_conv + (size_t)sb * 2 * FF2 + col); }
                if (cstate) { *(f32x4*)(cso + col) = uu[6]; *(f32x4*)(cso + FF2 + col) = uu[7]; }
                if (prompt && fr == 15) { float* ux = UX + ((size_t)u.pm * 8 + 2 * wr) * FF2 + col; *(f32x4*)ux = uu[6]; *(f32x4*)(ux + FF2) = uu[7]; }
                if (prompt && fr == 0) { float* ux = UX + ((size_t)u.pm * 8 + 4 + 2 * wr) * FF2 + col; *(f32x4*)ux = uu[0]; *(f32x4*)(ux + FF2) = uu[1]; }
#pragma unroll
                for (int j = 0; j < 8; ++j) { const f32x4 um1 = j >= 1 ? uu[j >= 1 ? j - 1 : 0] : p1, um2 = j >= 2 ? uu[j >= 2 ? j - 2 : 0] : (j == 1 ? p1 : p2);
                    const f32x4 c = cb + w2 * uu[j] + w1 * um1 + w0 * um2;
                    if (hf == 0) cv[j] = silu4(c); else cv[j] = cv[j] * c; }
            }
#pragma unroll
            for (int j = 0; j < 8; ++j) if (!(prompt && fr == 0 && j < 2)) *(u32x2*)(ACT + (size_t)(tok0 + j) * FF + ca) = pk4(cv[j]);
        }
    } };
struct UpOrder { int G, c;
    DI bool next(int i, pg8::Unit2& u) const { pg8::StaticOrder so; so.init(MT, FF2, G, c); pg8::Unit t; if (!so.next(i, t)) return false; u.pm = t.pm; u.pn = t.pn; u.kt0 = 0; u.nt = D / 64; return true; }
};
DI void phase_conv_fix(const P& p, int bid, int G) {
    int tid = mk_tid(p.hi); unsigned char* ws = p.ws; const float* UX = (const float*)(ws + WS_UX); bf16_t* ACT = (bf16_t*)(ws + WS_ACT);
    for (int i = bid * 512 + tid; i < 32 * 4 * (FF / 4); i += G * 512) {
        const int c4 = (i % (FF / 4)) * 4, rr = i / (FF / 4), pm = rr >> 2, wr = (rr >> 1) & 1, j = rr & 1;
        f32x4 cv;
#pragma unroll
        for (int hf = 0; hf < 2; ++hf) { const int col = c4 + hf * FF;
            const f32x4 w0 = *(const f32x4*)(p.conv_w + col), w1 = *(const f32x4*)(p.conv_w + FF2 + col), w2 = *(const f32x4*)(p.conv_w + 2 * FF2 + col), cb = *(const f32x4*)(p.conv_b + col);
            const float* own = UX + ((size_t)pm * 8 + 4 + 2 * wr) * FF2 + col;
            const f32x4 zero = (f32x4){0.f, 0.f, 0.f, 0.f};
            f32x4 q7, q6;
            if (wr == 1) { q6 = *(const f32x4*)(UX + ((size_t)pm * 8 + 0) * FF2 + col); q7 = *(const f32x4*)(UX + ((size_t)pm * 8 + 1) * FF2 + col); }
            else if ((pm & 7) == 0) { q6 = zero; q7 = zero; }
            else { q6 = *(const f32x4*)(UX + ((size_t)(pm - 1) * 8 + 2) * FF2 + col); q7 = *(const f32x4*)(UX + ((size_t)(pm - 1) * 8 + 3) * FF2 + col); }
            const f32x4 u0 = *(const f32x4*)own, u1 = *(const f32x4*)(own + FF2);
            const f32x4 c = j == 0 ? cb + w2 * u0 + w1 * q7 + w0 * q6 : cb + w2 * u1 + w1 * u0 + w0 * q7;
            if (hf == 0) cv = silu4(c); else cv = cv * c; }
        *(u32x2*)(ACT + (size_t)(pm * 256 + wr * 128 + j) * FF + c4) = pk4(cv);
    }
}
struct EpiDown { static constexpr bool PERM = false, AFTER_DRAIN = false; const float* H; float* Y;
    DI void operator()(EPI_ARGS) const {
        const int row0 = u.pm * 256 + wr * 64 + fr, col0 = u.pn * 256 + wc * 32 + 4 * fq;
#pragma unroll
        for (int ai = 0; ai < 2; ++ai)
#pragma unroll
            for (int m = 0; m < 4; ++m) { const size_t o = (size_t)(row0 + ai * 128 + m * 16) * D + col0;
#pragma unroll
                for (int bj = 0; bj < 2; ++bj)
#pragma unroll
                    for (int n = 0; n < 2; ++n) *(f32x4*)(Y + o + bj * 128 + n * 16) = *(const f32x4*)(H + o + bj * 128 + n * 16) + acc[ai][bj][m][n]; }
    } };

typedef pg8::Unit2 Unit2;
#define EPI2_ARGS const f32x4 (&acc)[2][2][4][2], const Unit2& u, int wr, int wc, int fr, int fq
struct EpiDown2 { static constexpr bool PERM = false, AFTER_DRAIN = false; const float* H; float* Y; float* SLAB;
    DI void operator()(EPI2_ARGS) const {
        const int row0 = u.pm * 256 + wr * 64 + fr, col0 = u.pn * 256 + wc * 32 + 4 * fq; const bool whole = u.nt == FF / 64;
#pragma unroll
        for (int ai = 0; ai < 2; ++ai)
#pragma unroll
            for (int m = 0; m < 4; ++m) { const size_t o = (size_t)(row0 + ai * 128 + m * 16) * D + col0;
#pragma unroll
                for (int bj = 0; bj < 2; ++bj)
#pragma unroll
                    for (int n = 0; n < 2; ++n) { float* y = Y + o + bj * 128 + n * 16; const f32x4 a = acc[ai][bj][m][n];
                        if (whole) *(f32x4*)y = *(const f32x4*)(H + o + bj * 128 + n * 16) + a;
                        else *(f32x4*)(SLAB + (size_t)(2 * (u.kt0 / 22) + (u.kt0 % 22 ? 1 : 0)) * NS * D + (o - (size_t)NP * D) + bj * 128 + n * 16) = a; } }
    } };
struct DownOrder { int G, c;
    DI bool next(int i, Unit2& u) const { const long L = (long)i * G + c;
        if (L < 256) { pg8::StaticOrder so; so.init(NP, D, 1, (int)L); pg8::Unit t; so.next(0, t); u.pm = t.pm; u.pn = t.pn; u.kt0 = 0; u.nt = FF / 64; return true; }
        if (L < 512) { const int q = (int)L - 256, tile = q >> 3, ks = q & 7; u.pm = 32 + (tile >> 3); u.pn = tile & 7; u.kt0 = (ks >> 1) * 22 + (ks & 1) * 12; u.nt = (ks & 1) ? 10 : 12; return true; }
        return false; }
};
struct CmpOrder { int G, c;
    DI bool next(int i, Unit& u) const { const long L = (long)i * G + c; if (L >= 1056) return false; const int l = (int)L, pair = (l >> 4) * 8 + (l & 7), pn = (l >> 3) & 1, cc = pair / 264;
        u.pm = pair; u.pn = cc * 2 + pn; return true; }
    DI void a_ready(const Unit&) const {}
    DI void done(const Unit&) const {}
};


struct CmpOrderS { int G, c, l0, l1, skip;
    DI bool next(int i, pg8::Unit2& u) const { const int n = l1 - l0, full = n / G, rem = n - full * G, sk = (rem + skip <= G) ? skip : 0;
        int l; if (i < full) l = l0 + i * G + c; else if (i == full && c >= sk && c - sk < rem) l = l0 + full * G + c - sk; else return false;
        const int x = l & 7, pn = (l >> 3) & 1, q = (l >> 4) & 15, cc = (q >> 1) & 1, bb = (l >> 8) * 32 + (q >> 2) * 8 + x;
        u.pm = cc * 264 + 8 + bb * 2 + (q & 1); u.pn = cc * 2 + pn; u.kt0 = 0; u.nt = 16; return true; }
};
struct CmpOrderP { int G, c;
    DI bool next(int i, Unit& u) const { const long L = (long)i * G + c; if (L >= 32) return false; const int l = (int)L, cc = l >> 4, r = l & 15; u.pm = cc * 264 + (r >> 1); u.pn = cc * 2 + (r & 1); return true; }
    DI void a_ready(const Unit&) const {}
    DI void done(const Unit&) const {}
};
struct EpiHpre2 { static constexpr bool PERM = true, AFTER_DRAIN = false; bf16_t* Hp;
    DI void operator()(const f32x4 (&acc)[2][2][4][2], const pg8::Unit2& u, int wr, int wc, int fr, int fq) const { EpiHpre E{Hp}; Unit t; t.pm = u.pm; t.pn = u.pn; E(acc, t, wr, wc, fr, fq); } };
__global__ void __launch_bounds__(512, 2) k_all(P p_in) {
    extern __shared__ __attribute__((aligned(16))) unsigned char lds_raw[];
    LAS unsigned char* lds = (LAS unsigned char*)lds_raw;
    const int wave_u = __builtin_amdgcn_readfirstlane((int)(threadIdx.x >> 6)); const int lo = p_in.lo, hi = p_in.hi; P p = p_in; p.hi = wave_u;
    const int bid = blockIdx.x, G = gridDim.x;
    { const int tid = mk_tid(wave_u); if (tid < 64) ((LAS unsigned*)(lds + LDS_MISC))[tid] = 0u; }
    __syncthreads();
    XcdBarrier bar; bar.wave = wave_u; bar.bar = (unsigned*)(p.ws + CTL_BAR); bar.x = 0; bar.st = nullptr;
    if (hi - lo > 1) bar = xcd_barrier_post((unsigned*)(p.ws + CTL_BAR), (volatile LAS unsigned*)(lds + LDS_MISC), wave_u);
#ifndef MK_PH_MASK
#define MK_PH_MASK 0x7ff
#endif
#define IN(k) (lo <= (k) && (k) < hi && ((MK_PH_MASK >> (k)) & 1))
#define SEAM(k) do { if (IN(k) && IN((k) + 1)) xcd_barrier(bar); } while (0)
    unsigned char* ws = p.ws;
#ifndef MK_DUP
#define MK_DUP -1
#endif
#ifndef MK_DUPF
#define MK_DUPF -1
#endif
#define CALLF(id, ...) do { __VA_ARGS__; if (MK_DUPF == (id)) { __syncthreads(); __VA_ARGS__; } } while (0)
#define PHASE(k, ...) do { if (IN(k)) { __VA_ARGS__; if (MK_DUP == (k)) { xcd_barrier(bar); if ((k) == 0) { if (bid == 0) ((float*)(ws + CTL_PEB))[mk_tid(wave_u)] = 0.f; } if ((k) == 5) { for (int i = bid * 512 + mk_tid(wave_u); i < MT; i += G * 512) ((float*)(ws + CTL_ROWSS))[i] = 0.f; } xcd_barrier(bar); __VA_ARGS__; } } SEAM(k); } while (0)
    PHASE(0, phase_prologue(p, lds, bid, G));
    PHASE(1, {
        const int Gg = G > 243 ? 243 : G, cut = bid % 5, nuS = (G - Gg >= 13) ? 960 : 1024;
        pg8::Gemm g{(const bf16_t*)(ws + WS_XG), (const bf16_t*)(ws + WS_W1T), MT, DINP, D}; EpiProj E{(const float*)(ws + WS_RSTD1), (const float*)(ws + WS_SINCOS), p.out, ws};
        if (bid < Gg && cut > 0) { ProjOrder S{Gg, bid, 0, cut}; pg8::gemm_phase2<EpiProj, ProjOrder, true>(lds, g, S, E, wave_u); }
        __syncthreads(); phase_slice(p, lds, bid, G, 0, G > 227 ? I1 + I2 : I1 + I2 + I3); __syncthreads();
        if (bid < Gg) { ProjOrder S{Gg, bid, cut, 1 << 20}; pg8::gemm_phase2<EpiProj, ProjOrder, true>(lds, g, S, E, wave_u); }
        else if (nuS < 1024) { CmpOrderS SH{G - Gg, bid - Gg, nuS, 1024, 0}; EpiHpre2 EH{(bf16_t*)(ws + WS_HPRE)};
            pg8::gemm_phase_cmpA<EpiHpre2, CmpOrderS>(lds, p.cache_kv, p.page_table, (const bf16_t*)(ws + WS_WC1T), SH, EH, wave_u); } });
    PHASE(2, {
        if (bid & 1) { phase_ret_kv_mfma(p, bid, G); __syncthreads(); }
        if (G == 256) {
            __syncthreads();
            if (mk_tid(wave_u) == 0) { unsigned* c = (unsigned*)(ws + CTL_PAIR) + ((bid >> 4) * 8 + (bid & 7)); __hip_atomic_fetch_add(c, 1u, __ATOMIC_RELAXED, __HIP_MEMORY_SCOPE_AGENT);
                for (int spin = 0; spin < 100000 && __hip_atomic_load(c, __ATOMIC_RELAXED, __HIP_MEMORY_SCOPE_AGENT) < 2u; ++spin) __builtin_amdgcn_s_sleep(2); }
            __syncthreads(); }
        { const int nuS = (G - (G > 243 ? 243 : G) >= 13) ? 960 : 1024; CmpOrderS S{G, bid, 0, nuS, 32}; EpiHpre2 E{(bf16_t*)(ws + WS_HPRE)};
          pg8::gemm_phase_cmpA<EpiHpre2, CmpOrderS>(lds, p.cache_kv, p.page_table, (const bf16_t*)(ws + WS_WC1T), S, E, wave_u);
          pg8::Gemm g{(const bf16_t*)(ws + WS_CBU), (const bf16_t*)(ws + WS_WC1T), 2 * CM, 1024, 1024}; CmpOrderP SP{G, bid}; EpiHpre EP{(bf16_t*)(ws + WS_HPRE)};
          pg8::gemm_phase<EpiHpre, CmpOrderP, true, true>(lds, g, SP, EP, wave_u); }
        if (!(bid & 1)) { __syncthreads(); phase_ret_kv_mfma(p, bid, G); } });
    PHASE(3, { CALLF(30, phase_cmp_l2_mfma(p, lds, bid, G)); CALLF(31, phase_ret_scan_t(p, bid, G)); });
    PHASE(4, {
        if (bid & 1) { phase_attn_sample(p, lds, bid, G); __syncthreads(); phase_attn_prompt(p, lds, bid, G, 0, 1 << 20); } else { phase_attn_prompt(p, lds, bid, G, 0, 1 << 20); __syncthreads(); phase_attn_sample(p, lds, bid, G); }
        __syncthreads(); CALLF(42, phase_ret_out_mfma(p, lds, bid, G)); });
    PHASE(5, {
        pg8::Gemm g{(const bf16_t*)(ws + WS_MIX), (const bf16_t*)(ws + WS_W2T), MT, D, D}; OutOrder S{G, bid};
        EpiOut E{p.x_prompt, p.x_sample, p.g_ffn, (float*)(ws + WS_H), (bf16_t*)(ws + WS_HG), (float*)(ws + CTL_ROWSS), (float*)(ws + WS_SLAB)};
        pg8::gemm_phase2<EpiOut, OutOrder, false>(lds, g, S, E, wave_u); });
    PHASE(6, phase_out_reduce(p, bid, G));
    PHASE(7, {
        const int Gg = G > 227 ? 227 : G;
        if (bid < Gg) { pg8::Gemm g{(const bf16_t*)(ws + WS_HG), (const bf16_t*)(ws + WS_W3T), MT, FF2, D}; UpOrder S{Gg, bid};
            EpiUpConv E{(bf16_t*)(ws + WS_ACT), (const float*)(ws + CTL_ROWSS), p.conv_w, p.conv_b, p.state_conv, p.out, (float*)(ws + WS_UX)};
            pg8::gemm_phase2<EpiUpConv, UpOrder, true>(lds, g, S, E, wave_u); }
        if (G == Gg) phase_win_copy(p, bid, G); else if (bid >= Gg) { phase_slice(p, lds, bid - Gg, G - Gg, I1 + I2, I1 + I2 + I3); __syncthreads(); phase_win_copy(p, bid - Gg, G - Gg); } });
    PHASE(8, phase_conv_fix(p, bid, G));
    PHASE(9, {
        pg8::Gemm g{(const bf16_t*)(ws + WS_ACT), (const bf16_t*)(ws + WS_W4T), MT, D, FF}; DownOrder S{G, bid};
        EpiDown2 E{(const float*)(ws + WS_H), p.out + O_Y, (float*)(ws + WS_SLAB)};
        pg8::gemm_phase2<EpiDown2, DownOrder, false>(lds, g, S, E, wave_u); });
    PHASE(10, { const float* H = (const float*)(ws + WS_H) + (size_t)NP * D; const float* SL = (const float*)(ws + WS_SLAB); float* Y = p.out + O_Y + (size_t)NP * D;
        for (int i = bid * 512 + mk_tid(wave_u); i < NS * D / 4; i += 2 * G * 512) { const size_t o = (size_t)i * 4, o2 = o + (size_t)G * 2048; const bool two = i + G * 512 < NS * D / 4;
            f32x4 y = *(const f32x4*)(H + o), y2 = two ? *(const f32x4*)(H + o2) : y; f32x4 a[8], b[8];
            _Pragma("unroll") for (int k = 0; k < 8; ++k) { a[k] = *(const f32x4*)(SL + (size_t)k * NS * D + o); b[k] = two ? *(const f32x4*)(SL + (size_t)k * NS * D + o2) : a[k]; }
            _Pragma("unroll") for (int k = 0; k < 8; ++k) { y += a[k]; y2 += b[k]; }
            *(f32x4*)(Y + o) = y; if (two) *(f32x4*)(Y + o2) = y2; } });
#undef IN
#undef SEAM
}
}

#ifndef MK_N_LAUNCHES
#define MK_N_LAUNCHES 1
#endif
extern "C" void kernel_launch(void* const* d_in, const int* in_sizes, int n_in, void* d_out, int out_size, void* d_ws, size_t ws_size, hipStream_t stream) {
    using namespace mk;
    static int grid = 0;
    if (grid == 0) {
        if (n_in != 25 || (size_t)out_size != O_END || ws_size < WS_END) { fprintf(stderr, "kernel_launch: unexpected problem (n_in %d, out %d vs %zu, ws %zu vs %zu); nothing launched\n", n_in, out_size, (size_t)O_END, ws_size, (size_t)WS_END); grid = -1; return; }
        int dev = 0, cus = 0, per_cu = 0;
        if (hipGetDevice(&dev) != hipSuccess || hipDeviceGetAttribute(&cus, hipDeviceAttributeMultiprocessorCount, dev) != hipSuccess) { grid = -1; return; }
        if (hipFuncSetAttribute((const void*)k_all, hipFuncAttributeMaxDynamicSharedMemorySize, LDS_BYTES) != hipSuccess) { fprintf(stderr, "kernel_launch: hipFuncSetAttribute failed\n"); grid = -1; return; }
        if (hipOccupancyMaxActiveBlocksPerMultiprocessor(&per_cu, (const void*)k_all, 512, LDS_BYTES) != hipSuccess || per_cu < 1) { fprintf(stderr, "kernel_launch: occupancy query reports %d workgroups per CU\n", per_cu); (void)hipGetLastError(); grid = -1; return; }
        grid = cus;
    }
    if (grid < 0) return;
    (void)hipMemsetAsync((char*)d_ws + WS_CTL, 0, CTL_BYTES, stream);
    P p{};
    p.x_prompt = (const float*)d_in[0]; p.x_sample = (const float*)d_in[1]; p.cache_kv = (const float*)d_in[2]; p.cache_win = (const float*)d_in[3]; p.state_ret = (const float*)d_in[4];
    p.state_conv = (const float*)d_in[5]; p.page_table = (const int*)d_in[6]; p.g_attn = (const float*)d_in[7]; p.w_in = (const float*)d_in[8]; p.q_norm = (const float*)d_in[9];
    p.k_norm_cmp = (const float*)d_in[10]; p.k_norm_slc = (const float*)d_in[11]; p.k_norm_win = (const float*)d_in[12]; p.cmp_pe = (const float*)d_in[13]; p.cmp_w1 = (const float*)d_in[14];
    p.cmp_b1 = (const float*)d_in[15]; p.cmp_w2 = (const float*)d_in[16]; p.cmp_b2 = (const float*)d_in[17]; p.ret_gn = (const float*)d_in[18]; p.w_out = (const float*)d_in[19];
    p.g_ffn = (const float*)d_in[20]; p.w_up = (const float*)d_in[21]; p.conv_w = (const float*)d_in[22]; p.conv_b = (const float*)d_in[23]; p.w_down = (const float*)d_in[24];
    p.out = (float*)d_out; p.ws = (unsigned char*)d_ws;
    constexpr int NPH = 11;
    for (int li = 0; li < MK_N_LAUNCHES; ++li) {
        p.lo = (MK_N_LAUNCHES == 1) ? 0 : li; p.hi = (MK_N_LAUNCHES == 1) ? NPH : li + 1;
        hipLaunchKernelGGL(k_all, dim3(grid), dim3(512), LDS_BYTES, stream, p);
        const hipError_t le = hipPeekAtLastError();
        if (le != hipSuccess) { fprintf(stderr, "kernel_launch: launch %d failed: %s\n", li, hipGetErrorName(le)); break; }
    }
}
```

```cpp
#include <hip/hip_runtime.h>
#include <cstdio>
#include <cstdint>
namespace pg8 {
#define PG8_LAS __attribute__((address_space(3)))
typedef unsigned short bf16_t;
typedef short bf16x8 __attribute__((ext_vector_type(8)));
typedef float f32x4 __attribute__((ext_vector_type(4)));
typedef unsigned u32x4 __attribute__((ext_vector_type(4)));
constexpr int BM = 256, BK = 64, HALF = 128, HTB = HALF * BK * 2  , STAGE_BYTES = 8 * HTB, NXCD = 8, WGM = 4;

__host__ __device__ __forceinline__ int lds_byte(int r, int c) { const int st = (r >> 4) * 2 + (c >> 5), rr = r & 15, cc = c & 31, ob = rr * 64 + cc * 2; return st * 1024 + (ob ^ (((ob >> 9) & 1) << 5)); }
__host__ __device__ __forceinline__ void stage_rc(int b, int& R, int& C) { const int st = b / 1024, sb = b % 1024, swz = sb ^ (((sb >> 9) & 1) << 5); R = (st >> 1) * 16 + swz / 64; C = (st & 1) * 32 + (swz % 64) / 2; }
__host__ __device__ __forceinline__ int perm32(int rho) { const int n = rho >> 4, i = rho & 15; return 8 * (i >> 2) + 4 * n + (i & 3); }

struct Unit { int pm, pn; };
struct Gemm { const bf16_t* A; const bf16_t* Bt; int M, N, K; };

struct StaticOrder {
    int nM, nN, nwg, G, c;
    __host__ __device__ void init(int M, int N, int G_, int c_) { nM = M / BM; nN = N / BM; nwg = nM * nN; G = G_; c = c_; }
    __host__ __device__ bool next(int i, Unit& u) const {
        const long L = (long)i * G + c; if (L >= nwg) return false;
        int wgid = (int)L; { const int q = nwg / NXCD, r = nwg % NXCD, xcd = wgid % NXCD, off = wgid / NXCD; wgid = (xcd < r ? xcd * (q + 1) : r * (q + 1) + (xcd - r) * q) + off; }
        const int nig = WGM * nN, gid = wgid / nig, fm = gid * WGM, gsz = (nM - fm) < WGM ? (nM - fm) : WGM;
        u.pm = fm + ((wgid % nig) % gsz); u.pn = (wgid % nig) / gsz; return true;
    }
    __device__ __forceinline__ void a_ready(const Unit&) const {}
    __device__ __forceinline__ void done(const Unit&) const {}
};
__device__ __forceinline__ unsigned cvt_pk_bf16(float lo, float hi) { unsigned r; asm volatile("v_cvt_pk_bf16_f32 %0, %1, %2" : "=v"(r) : "v"(lo), "v"(hi)); return r; }
template <class Epi, class Sched, bool ALIGN_EPI = false, bool SP2 = false>
__device__ __forceinline__ void gemm_phase(PG8_LAS unsigned char* lds, const Gemm g, const Sched& S, const Epi& E, const int wid) {
    int lane; asm volatile("v_mbcnt_lo_u32_b32 %0, -1, 0\n\tv_mbcnt_hi_u32_b32 %0, -1, %0" : "=v"(lane)); const int tid = wid * 64 + lane, wr = wid >> 2, wc = wid & 3, fr = lane & 15, fq = lane >> 4;
    const int K = g.K, nt = K / BK;
    unsigned voffA[2], voffB[2];
#pragma unroll
    for (int i = 0; i < 2; ++i) { int R, C; stage_rc(tid * 16 + i * 8192, R, C); const int Rb = Epi::PERM ? ((R & ~31) + perm32(R & 31)) : R;
        voffA[i] = (unsigned)(R * K + C) * 2u; voffB[i] = (unsigned)(Rb * K + C) * 2u; }
    const size_t kstep = (size_t)(BK * 2);
    const size_t hstep = (size_t)HALF * K * 2;
    const size_t tstep = 2 * hstep;
    const unsigned ldsw = (unsigned)wid * 1024u;
    const int aoff = lds_byte(wr * 64 + fr, fq * 8), boff = lds_byte(wc * 32 + fr, fq * 8);
#define PG8_SA(b, h) (((b) * 2 + (h)) * HTB)
#define PG8_SB(b, h) ((4 + (b) * 2 + (h)) * HTB)
#define PG8_STAGE(bufoff, gbase, voff) do { _Pragma("unroll") for (int _i = 0; _i < 2; ++_i) \
        __builtin_amdgcn_global_load_lds((const unsigned*)((const char*)(gbase) + (voff)[_i]), (PG8_LAS unsigned*)(lds + (bufoff) + ldsw + _i * 8192), 16, 0, 0); } while (0)
#define PG8_LDA(dst, b, h) do { _Pragma("unroll") for (int m = 0; m < 4; ++m) _Pragma("unroll") for (int k = 0; k < 2; ++k) dst[m][k] = *(const PG8_LAS bf16x8*)(lds + PG8_SA(b, h) + aoff + m * 2048 + k * 1024); } while (0)
#define PG8_LDB(dst, b, h) do { _Pragma("unroll") for (int n = 0; n < 2; ++n) _Pragma("unroll") for (int k = 0; k < 2; ++k) dst[n][k] = *(const PG8_LAS bf16x8*)(lds + PG8_SB(b, h) + boff + n * 2048 + k * 1024); } while (0)
#define PG8_MMA(ai, bj, At, Bt) do { __builtin_amdgcn_s_setprio(1); _Pragma("unroll") for (int m = 0; m < 4; ++m) _Pragma("unroll") for (int n = 0; n < 2; ++n) _Pragma("unroll") for (int k = 0; k < 2; ++k) \
        acc[ai][bj][m][n] = __builtin_amdgcn_mfma_f32_16x16x32_bf16(Bt[n][k], At[m][k], acc[ai][bj][m][n], 0, 0, 0); __builtin_amdgcn_s_setprio(0); } while (0)
#define PG8_WAIT_V(n) asm volatile("s_waitcnt vmcnt(" #n ")" ::: "memory")
#define PG8_WAIT_L(n) asm volatile("s_waitcnt lgkmcnt(" #n ")" ::: "memory")
#define PG8_BAR __builtin_amdgcn_s_barrier()
#define PG8_SCHED __builtin_amdgcn_sched_barrier(0)
    Unit cur, nxt; int ui = 0;
    if (!S.next(0, cur)) return;
    f32x4 acc[2][2][4][2];
#pragma unroll
    for (int a = 0; a < 2; ++a)
#pragma unroll
        for (int b = 0; b < 2; ++b)
#pragma unroll
            for (int m = 0; m < 4; ++m)
#pragma unroll
                for (int n = 0; n < 2; ++n) acc[a][b][m][n] = (f32x4){0.f, 0.f, 0.f, 0.f};
    bf16x8 At[4][2], B0[2][2], B1[2][2];
    const char* cA = (const char*)g.A + (size_t)cur.pm * tstep; const char* cB = (const char*)g.Bt + (size_t)cur.pn * tstep;
    S.a_ready(cur);
    if constexpr (SP2) {
        PG8_STAGE(PG8_SB(0, 0), cB, voffB); PG8_STAGE(PG8_SB(0, 1), cB + hstep, voffB); PG8_STAGE(PG8_SA(0, 0), cA, voffA); PG8_STAGE(PG8_SA(0, 1), cA + hstep, voffA);
        if (wr == 1) PG8_BAR;
        PG8_WAIT_V(2); PG8_BAR;
        PG8_STAGE(PG8_SB(1, 0), cB + kstep, voffB); PG8_STAGE(PG8_SA(1, 0), cA + kstep, voffA); PG8_STAGE(PG8_SB(1, 1), cB + hstep + kstep, voffB);
        PG8_WAIT_V(6); PG8_BAR;
    } else {
        PG8_STAGE(PG8_SB(0, 0), cB, voffB); PG8_STAGE(PG8_SA(0, 0), cA, voffA); PG8_STAGE(PG8_SB(0, 1), cB + hstep, voffB); PG8_STAGE(PG8_SA(0, 1), cA + hstep, voffA);
        if (wr == 1) PG8_BAR;
        PG8_WAIT_V(4); PG8_BAR;
        PG8_STAGE(PG8_SB(1, 0), cB + kstep, voffB); PG8_STAGE(PG8_SA(1, 0), cA + kstep, voffA); PG8_STAGE(PG8_SB(1, 1), cB + hstep + kstep, voffB);
        PG8_WAIT_V(6); PG8_BAR;
    }
    for (;;) {
        const bool has_next = S.next(ui + 1, nxt);
        const char* nA = has_next ? (const char*)g.A + (size_t)nxt.pm * tstep : cA; const char* nB = has_next ? (const char*)g.Bt + (size_t)nxt.pn * tstep : cB;
        for (int t = 0; t < nt; t += 2) {
            const bool last = (t == nt - 2);
            const char* a1 = cA + (size_t)(t + 1) * kstep;
            const char* a2 = last ? nA : cA + (size_t)(t + 2) * kstep; const char* b2 = last ? nB : cB + (size_t)(t + 2) * kstep;
            const char* a3 = a2 + kstep; const char* b3 = b2 + kstep;
            if (last && has_next) S.a_ready(nxt);
            if constexpr (SP2) {
            PG8_LDB(B0, 0, 0); PG8_LDB(B1, 0, 1); PG8_SCHED; PG8_LDA(At, 0, 0); PG8_STAGE(PG8_SA(1, 1), a1 + hstep, voffA);
            PG8_WAIT_V(8); PG8_WAIT_L(0); PG8_BAR; PG8_MMA(0, 0, At, B0); PG8_MMA(0, 1, At, B1); PG8_BAR; PG8_SCHED;
            PG8_LDA(At, 0, 1); PG8_STAGE(PG8_SB(0, 0), b2, voffB); PG8_STAGE(PG8_SB(0, 1), b2 + hstep, voffB); PG8_STAGE(PG8_SA(0, 0), a2, voffA);
            PG8_WAIT_V(8); PG8_WAIT_L(0); PG8_BAR; PG8_MMA(1, 0, At, B0); PG8_MMA(1, 1, At, B1); PG8_BAR; PG8_SCHED;
            PG8_LDB(B0, 1, 0); PG8_LDB(B1, 1, 1); PG8_SCHED; PG8_LDA(At, 1, 0); PG8_STAGE(PG8_SA(0, 1), a2 + hstep, voffA);
            PG8_WAIT_V(8); PG8_WAIT_L(0); PG8_BAR; PG8_MMA(0, 0, At, B0); PG8_MMA(0, 1, At, B1); PG8_BAR; PG8_SCHED;
            PG8_LDA(At, 1, 1); PG8_STAGE(PG8_SB(1, 0), b3, voffB); PG8_STAGE(PG8_SB(1, 1), b3 + hstep, voffB); PG8_STAGE(PG8_SA(1, 0), a3, voffA);
            PG8_WAIT_V(8); PG8_WAIT_L(0); PG8_BAR; PG8_MMA(1, 0, At, B0); PG8_MMA(1, 1, At, B1); PG8_BAR; PG8_SCHED;
            } else {
            PG8_LDB(B0, 0, 0); PG8_SCHED; PG8_LDA(At, 0, 0); PG8_STAGE(PG8_SA(1, 1), a1 + hstep, voffA);
            PG8_WAIT_L(8); PG8_BAR; PG8_WAIT_L(0); PG8_MMA(0, 0, At, B0); PG8_BAR; PG8_SCHED;
            PG8_LDB(B1, 0, 1); PG8_STAGE(PG8_SB(0, 0), b2, voffB);
            PG8_BAR; PG8_WAIT_L(0); PG8_MMA(0, 1, At, B1); PG8_BAR;
            PG8_LDA(At, 0, 1); PG8_STAGE(PG8_SA(0, 0), a2, voffA);
            PG8_BAR; PG8_WAIT_L(0); PG8_MMA(1, 0, At, B0); PG8_BAR; PG8_SCHED;
            PG8_STAGE(PG8_SB(0, 1), b2 + hstep, voffB);
            PG8_WAIT_V(6); PG8_BAR; PG8_MMA(1, 1, At, B1); PG8_BAR;
            PG8_LDB(B0, 1, 0); PG8_SCHED; PG8_LDA(At, 1, 0); PG8_STAGE(PG8_SA(0, 1), a2 + hstep, voffA);
            PG8_WAIT_L(8); PG8_BAR; PG8_WAIT_L(0); PG8_MMA(0, 0, At, B0); PG8_BAR; PG8_SCHED;
            PG8_LDB(B1, 1, 1); PG8_STAGE(PG8_SB(1, 0), b3, voffB);
            PG8_BAR; PG8_WAIT_L(0); PG8_MMA(0, 1, At, B1); PG8_BAR;
            PG8_LDA(At, 1, 1); PG8_STAGE(PG8_SA(1, 0), a3, voffA);
            PG8_BAR; PG8_WAIT_L(0); PG8_MMA(1, 0, At, B0); PG8_BAR; PG8_SCHED;
            PG8_STAGE(PG8_SB(1, 1), b3 + hstep, voffB);
            PG8_WAIT_V(6); PG8_BAR; PG8_MMA(1, 1, At, B1); PG8_BAR;
            }
        }
        if constexpr (ALIGN_EPI) { if (wr == 0) PG8_BAR; }
        if constexpr (!Epi::AFTER_DRAIN) { E(acc, cur, wr, wc, fr, fq); S.done(cur); }
        if (!has_next) break;
#pragma unroll
        for (int a = 0; a < 2; ++a)
#pragma unroll
            for (int b = 0; b < 2; ++b)
#pragma unroll
                for (int m = 0; m < 4; ++m)
#pragma unroll
                    for (int n = 0; n < 2; ++n) acc[a][b][m][n] = (f32x4){0.f, 0.f, 0.f, 0.f};
        cur = nxt; cA = nA; cB = nB; ++ui;
        if constexpr (ALIGN_EPI) { if (wr == 1) PG8_BAR; }
    }
    PG8_WAIT_V(0);
    if constexpr (!ALIGN_EPI) { if (wr == 0) PG8_BAR; }
    PG8_BAR;
    if constexpr (Epi::AFTER_DRAIN) { E.fused(acc, cur, wr, wc, fr, fq, lds, wid, lane); S.done(cur); }
#undef PG8_SA
#undef PG8_SB
#undef PG8_STAGE
#undef PG8_LDA
#undef PG8_LDB
#undef PG8_MMA
#undef PG8_WAIT_V
#undef PG8_WAIT_L
#undef PG8_BAR
#undef PG8_SCHED
}
}

namespace pg8 {
struct Unit2 { int pm, pn, kt0, nt; };
template <class Epi, class Sched, bool ROWPERM = false>
__device__ __forceinline__ void gemm_phase2(PG8_LAS unsigned char* lds, const Gemm g, const Sched& S, const Epi& E, const int wid) {
    int lane; asm volatile("v_mbcnt_lo_u32_b32 %0, -1, 0\n\tv_mbcnt_hi_u32_b32 %0, -1, %0" : "=v"(lane)); const int tid = wid * 64 + lane, wr = wid >> 2, wc = wid & 3, fr = lane & 15, fq = lane >> 4;
    const int K = g.K;
    unsigned voffA[2], voffB[2];
#pragma unroll
    for (int i = 0; i < 2; ++i) { int R, C; stage_rc(tid * 16 + i * 8192, R, C); const int Rb = Epi::PERM ? ((R & ~31) + perm32(R & 31)) : R;
        const int Ra = ROWPERM ? (128 * (R >> 6) + 8 * (R & 15) + ((R >> 4) & 3)) : R;
        voffA[i] = (unsigned)(Ra * K + C) * 2u; voffB[i] = (unsigned)(Rb * K + C) * 2u; }
    const size_t kstep = (size_t)(BK * 2);
    const size_t hstepB = (size_t)HALF * K * 2, hstepA = ROWPERM ? (size_t)4 * K * 2 : hstepB;
    const size_t tstep = (size_t)BM * K * 2;
    const unsigned ldsw = (unsigned)wid * 1024u;
    const int aoff = lds_byte(wr * 64 + fr, fq * 8), boff = lds_byte(wc * 32 + fr, fq * 8);
#define PG8_SA(b, h) (((b) * 2 + (h)) * HTB)
#define PG8_SB(b, h) ((4 + (b) * 2 + (h)) * HTB)
#define PG8_STAGE(bufoff, gbase, voff) do { _Pragma("unroll") for (int _i = 0; _i < 2; ++_i) \
        __builtin_amdgcn_global_load_lds((const unsigned*)((const char*)(gbase) + (voff)[_i]), (PG8_LAS unsigned*)(lds + (bufoff) + ldsw + _i * 8192), 16, 0, 0); } while (0)
#define PG8_LDA(dst, b, h) do { _Pragma("unroll") for (int m = 0; m < 4; ++m) _Pragma("unroll") for (int k = 0; k < 2; ++k) dst[m][k] = *(const PG8_LAS bf16x8*)(lds + PG8_SA(b, h) + aoff + m * 2048 + k * 1024); } while (0)
#define PG8_LDB(dst, b, h) do { _Pragma("unroll") for (int n = 0; n < 2; ++n) _Pragma("unroll") for (int k = 0; k < 2; ++k) dst[n][k] = *(const PG8_LAS bf16x8*)(lds + PG8_SB(b, h) + boff + n * 2048 + k * 1024); } while (0)
#define PG8_MMA(ai, bj, At, Bt) do { __builtin_amdgcn_s_setprio(1); _Pragma("unroll") for (int m = 0; m < 4; ++m) _Pragma("unroll") for (int n = 0; n < 2; ++n) _Pragma("unroll") for (int k = 0; k < 2; ++k) \
        acc[ai][bj][m][n] = __builtin_amdgcn_mfma_f32_16x16x32_bf16(Bt[n][k], At[m][k], acc[ai][bj][m][n], 0, 0, 0); __builtin_amdgcn_s_setprio(0); } while (0)
#define PG8_WAIT_V(n) asm volatile("s_waitcnt vmcnt(" #n ")" ::: "memory")
#define PG8_WAIT_L(n) asm volatile("s_waitcnt lgkmcnt(" #n ")" ::: "memory")
#define PG8_BAR __builtin_amdgcn_s_barrier()
#define PG8_SCHED __builtin_amdgcn_sched_barrier(0)
    Unit2 cur, nxt; int ui = 0;
    if (!S.next(0, cur)) return;
    f32x4 acc[2][2][4][2];
#pragma unroll
    for (int a = 0; a < 2; ++a)
#pragma unroll
        for (int b = 0; b < 2; ++b)
#pragma unroll
            for (int m = 0; m < 4; ++m)
#pragma unroll
                for (int n = 0; n < 2; ++n) acc[a][b][m][n] = (f32x4){0.f, 0.f, 0.f, 0.f};
    bf16x8 At[4][2], B0[2][2], B1[2][2];
    const char* cA = (const char*)g.A + (size_t)cur.pm * tstep + (size_t)cur.kt0 * kstep; const char* cB = (const char*)g.Bt + (size_t)cur.pn * tstep + (size_t)cur.kt0 * kstep;
    PG8_STAGE(PG8_SB(0, 0), cB, voffB); PG8_STAGE(PG8_SB(0, 1), cB + hstepB, voffB); PG8_STAGE(PG8_SA(0, 0), cA, voffA); PG8_STAGE(PG8_SA(0, 1), cA + hstepA, voffA);
    if (wr == 1) PG8_BAR;
    PG8_WAIT_V(2); PG8_BAR;
    PG8_STAGE(PG8_SB(1, 0), cB + kstep, voffB); PG8_STAGE(PG8_SA(1, 0), cA + kstep, voffA); PG8_STAGE(PG8_SB(1, 1), cB + hstepB + kstep, voffB);
    PG8_WAIT_V(6); PG8_BAR;
    for (;;) {
        const bool has_next = S.next(ui + 1, nxt);
        const char* nA = has_next ? (const char*)g.A + (size_t)nxt.pm * tstep + (size_t)nxt.kt0 * kstep : cA; const char* nB = has_next ? (const char*)g.Bt + (size_t)nxt.pn * tstep + (size_t)nxt.kt0 * kstep : cB;
        const int nt = cur.nt;
        for (int t = 0; t < nt; t += 2) {
            const bool last = (t == nt - 2);
            const char* a1 = cA + (size_t)(t + 1) * kstep;
            const char* a2 = last ? nA : cA + (size_t)(t + 2) * kstep; const char* b2 = last ? nB : cB + (size_t)(t + 2) * kstep;
            const char* a3 = a2 + kstep; const char* b3 = b2 + kstep;
            PG8_LDB(B0, 0, 0); PG8_LDB(B1, 0, 1); PG8_SCHED; PG8_LDA(At, 0, 0); PG8_STAGE(PG8_SA(1, 1), a1 + hstepA, voffA);
            PG8_WAIT_V(8); PG8_WAIT_L(0); PG8_BAR; PG8_MMA(0, 0, At, B0); PG8_MMA(0, 1, At, B1); PG8_BAR; PG8_SCHED;
            PG8_LDA(At, 0, 1); PG8_STAGE(PG8_SB(0, 0), b2, voffB); PG8_STAGE(PG8_SB(0, 1), b2 + hstepB, voffB); PG8_STAGE(PG8_SA(0, 0), a2, voffA);
            PG8_WAIT_V(8); PG8_WAIT_L(0); PG8_BAR; PG8_MMA(1, 0, At, B0); PG8_MMA(1, 1, At, B1); PG8_BAR; PG8_SCHED;
            PG8_LDB(B0, 1, 0); PG8_LDB(B1, 1, 1); PG8_SCHED; PG8_LDA(At, 1, 0); PG8_STAGE(PG8_SA(0, 1), a2 + hstepA, voffA);
            PG8_WAIT_V(8); PG8_WAIT_L(0); PG8_BAR; PG8_MMA(0, 0, At, B0); PG8_MMA(0, 1, At, B1); PG8_BAR; PG8_SCHED;
            PG8_LDA(At, 1, 1); PG8_STAGE(PG8_SB(1, 0), b3, voffB); PG8_STAGE(PG8_SB(1, 1), b3 + hstepB, voffB); PG8_STAGE(PG8_SA(1, 0), a3, voffA);
            PG8_WAIT_V(8); PG8_WAIT_L(0); PG8_BAR; PG8_MMA(1, 0, At, B0); PG8_MMA(1, 1, At, B1); PG8_BAR; PG8_SCHED;
        }
        if (wr == 0) PG8_BAR;
        E(acc, cur, wr, wc, fr, fq);
        if (!has_next) break;
#pragma unroll
        for (int a = 0; a < 2; ++a)
#pragma unroll
            for (int b = 0; b < 2; ++b)
#pragma unroll
                for (int m = 0; m < 4; ++m)
#pragma unroll
                    for (int n = 0; n < 2; ++n) acc[a][b][m][n] = (f32x4){0.f, 0.f, 0.f, 0.f};
        cur = nxt; cA = nA; cB = nB; ++ui;
        if (wr == 1) PG8_BAR;
    }
    PG8_WAIT_V(0);
    PG8_BAR;
#undef PG8_SA
#undef PG8_SB
#undef PG8_STAGE
#undef PG8_LDA
#undef PG8_LDB
#undef PG8_MMA
#undef PG8_WAIT_V
#undef PG8_WAIT_L
#undef PG8_BAR
#undef PG8_SCHED
}
}

namespace pg8 {
typedef float f32x4g __attribute__((ext_vector_type(4)));
template <class Epi, class Sched>
__device__ __forceinline__ void gemm_phase_cmpA(PG8_LAS unsigned char* lds, const float* cache_kv, const int* page_table, const bf16_t* Bt, const Sched& S, const Epi& E, const int wid) {
    int lane; asm volatile("v_mbcnt_lo_u32_b32 %0, -1, 0\n\tv_mbcnt_hi_u32_b32 %0, -1, %0" : "=v"(lane)); const int tid = wid * 64 + lane, wr = wid >> 2, wc = wid & 3, fr = lane & 15, fq = lane >> 4;
    constexpr int K = 1024;
    unsigned voffB[2];
#pragma unroll
    for (int i = 0; i < 2; ++i) { int R, C; stage_rc(tid * 16 + i * 8192, R, C); const int Rb = Epi::PERM ? ((R & ~31) + perm32(R & 31)) : R; voffB[i] = (unsigned)(Rb * K + C) * 2u; }
    const size_t kstepB = (size_t)(BK * 2), hstepB = (size_t)HALF * K * 2, tstepB = (size_t)BM * K * 2;
    const unsigned ldsw = (unsigned)wid * 1024u, ldst = (unsigned)tid * 16u;
    const int aoff = lds_byte(wr * 64 + fr, fq * 8), boff = lds_byte(wc * 32 + fr, fq * 8);
    const char* cbase = (const char*)cache_kv;
#define PG8_SA(b, h) (((b) * 2 + (h)) * HTB)
#define PG8_SB(b, h) ((4 + (b) * 2 + (h)) * HTB)
#define PG8_STAGE(bufoff, gbase, voff) do { _Pragma("unroll") for (int _i = 0; _i < 2; ++_i) \
        __builtin_amdgcn_global_load_lds((const unsigned*)((const char*)(gbase) + (voff)[_i]), (PG8_LAS unsigned*)(lds + (bufoff) + ldsw + _i * 8192), 16, 0, 0); } while (0)
#define PG8_ALOAD(r, off, h, kt) do { _Pragma("unroll") for (int _i = 0; _i < 2; ++_i) { const unsigned _o = (off)[h][_i] + (unsigned)(kt) * 4096u;        \
        asm volatile("s_nop 4\n\tglobal_load_dwordx4 %0, %2, %3\n\tglobal_load_dwordx4 %1, %2, %3 offset:16" : "=&v"(r[2 * _i]), "=&v"(r[2 * _i + 1]) : "v"(_o), "s"(cbase) : "memory"); } } while (0)
#define PG8_WAIT_VR(n, r) asm volatile("s_waitcnt vmcnt(" #n ")" : "+v"(r[0]), "+v"(r[1]), "+v"(r[2]), "+v"(r[3]) :: "memory")
#define PG8_AWRITE(r, bufoff) do { _Pragma("unroll") for (int _i = 0; _i < 2; ++_i) { u32x4 _w; _w.x = cvt_pk_bf16(r[2 * _i][0], r[2 * _i][1]); _w.y = cvt_pk_bf16(r[2 * _i][2], r[2 * _i][3]); \
        _w.z = cvt_pk_bf16(r[2 * _i + 1][0], r[2 * _i + 1][1]); _w.w = cvt_pk_bf16(r[2 * _i + 1][2], r[2 * _i + 1][3]); *(PG8_LAS u32x4*)(lds + (bufoff) + ldst + _i * 8192) = _w; } } while (0)
#define PG8_LDA(dst, b, h) do { _Pragma("unroll") for (int m = 0; m < 4; ++m) _Pragma("unroll") for (int k = 0; k < 2; ++k) dst[m][k] = *(const PG8_LAS bf16x8*)(lds + PG8_SA(b, h) + aoff + m * 2048 + k * 1024); } while (0)
#define PG8_LDB(dst, b, h) do { _Pragma("unroll") for (int n = 0; n < 2; ++n) _Pragma("unroll") for (int k = 0; k < 2; ++k) dst[n][k] = *(const PG8_LAS bf16x8*)(lds + PG8_SB(b, h) + boff + n * 2048 + k * 1024); } while (0)
#define PG8_MMA(ai, bj, At, Bt_) do { __builtin_amdgcn_s_setprio(1); _Pragma("unroll") for (int m = 0; m < 4; ++m) _Pragma("unroll") for (int n = 0; n < 2; ++n) _Pragma("unroll") for (int k = 0; k < 2; ++k) \
        acc[ai][bj][m][n] = __builtin_amdgcn_mfma_f32_16x16x32_bf16(Bt_[n][k], At[m][k], acc[ai][bj][m][n], 0, 0, 0); __builtin_amdgcn_s_setprio(0); } while (0)
#define PG8_WAIT_V(n) asm volatile("s_waitcnt vmcnt(" #n ")" ::: "memory")
#define PG8_WAIT_L(n) asm volatile("s_waitcnt lgkmcnt(" #n ")" ::: "memory")
#define PG8_BAR __builtin_amdgcn_s_barrier()
#define PG8_SCHED __builtin_amdgcn_sched_barrier(0)
#define PG8_AOFFS(off, u) do { const int _c = (u).pm / 264, _t = (u).pm % 264, _b = (_t >> 1) - 4, _g0 = 2 * (_t & 1); \
        int _ln; asm volatile("v_mbcnt_lo_u32_b32 %0, -1, 0\n\tv_mbcnt_hi_u32_b32 %0, -1, %0" : "=v"(_ln));        \
        _Pragma("unroll") for (int _i = 0; _i < 2; ++_i) { int _ra, _ca; stage_rc((wid * 64 + _ln) * 16 + _i * 8192, _ra, _ca); \
            const unsigned _base = ((unsigned)page_table[_b * 16 + (_ra >> 3)] * 128u + (unsigned)((_ra & 7) * 16)) * 4096u + (unsigned)(_c * 1024 + _g0 * 256 + _ca * 4); \
            (off)[0][_i] = _base; (off)[1][_i] = _base + 256u; } } while (0)
    Unit2 cur, nxt; int ui = 0;
    if (!S.next(0, cur)) return;
    f32x4 acc[2][2][4][2];
#pragma unroll
    for (int a = 0; a < 2; ++a)
#pragma unroll
        for (int b = 0; b < 2; ++b)
#pragma unroll
            for (int m = 0; m < 4; ++m)
#pragma unroll
                for (int n = 0; n < 2; ++n) acc[a][b][m][n] = (f32x4){0.f, 0.f, 0.f, 0.f};
    bf16x8 At[4][2], B0[2][2], B1[2][2];
    f32x4g RX[4], RY[4];
    unsigned cO[2][2], nO[2][2];
    PG8_AOFFS(cO, cur);
    const char* cB = (const char*)Bt + (size_t)cur.pn * tstepB;
    PG8_STAGE(PG8_SB(0, 0), cB, voffB); PG8_STAGE(PG8_SB(0, 1), cB + hstepB, voffB); PG8_ALOAD(RY, cO, 0, 0); PG8_ALOAD(RX, cO, 1, 0);
    if (wr == 1) PG8_BAR;
    PG8_WAIT_VR(4, RY); PG8_AWRITE(RY, PG8_SA(0, 0));
    PG8_STAGE(PG8_SB(1, 0), cB + kstepB, voffB); PG8_STAGE(PG8_SB(1, 1), cB + hstepB + kstepB, voffB); PG8_ALOAD(RY, cO, 0, 1);
    PG8_WAIT_L(0); PG8_BAR;
    for (;;) {
        const bool has_next = S.next(ui + 1, nxt);
        if (has_next) PG8_AOFFS(nO, nxt); else { _Pragma("unroll") for (int _h = 0; _h < 2; ++_h) _Pragma("unroll") for (int _i = 0; _i < 2; ++_i) nO[_h][_i] = cO[_h][_i]; }
        const char* nB = has_next ? (const char*)Bt + (size_t)nxt.pn * tstepB : cB;
        const int nt = K / BK;
        for (int t = 0; t < nt; t += 2) {
            const bool last = (t == nt - 2);
            const char* b2 = last ? nB : cB + (size_t)(t + 2) * kstepB; const char* b3 = b2 + kstepB;
            PG8_LDB(B0, 0, 0); PG8_LDB(B1, 0, 1); PG8_SCHED; PG8_LDA(At, 0, 0);
            PG8_WAIT_VR(8, RX); PG8_AWRITE(RX, PG8_SA(0, 1)); PG8_ALOAD(RX, cO, 1, t + 1);
            PG8_WAIT_L(0); PG8_BAR; PG8_MMA(0, 0, At, B0); PG8_MMA(0, 1, At, B1); PG8_BAR; PG8_SCHED;
            PG8_LDA(At, 0, 1); PG8_STAGE(PG8_SB(0, 0), b2, voffB); PG8_STAGE(PG8_SB(0, 1), b2 + hstepB, voffB);
            PG8_WAIT_VR(8, RY); PG8_AWRITE(RY, PG8_SA(1, 0)); if (last) PG8_ALOAD(RY, nO, 0, 0); else PG8_ALOAD(RY, cO, 0, t + 2);
            PG8_WAIT_L(0); PG8_BAR; PG8_MMA(1, 0, At, B0); PG8_MMA(1, 1, At, B1); PG8_BAR; PG8_SCHED;
            PG8_LDB(B0, 1, 0); PG8_LDB(B1, 1, 1); PG8_SCHED; PG8_LDA(At, 1, 0);
            PG8_WAIT_VR(8, RX); PG8_AWRITE(RX, PG8_SA(1, 1)); if (last) PG8_ALOAD(RX, nO, 1, 0); else PG8_ALOAD(RX, cO, 1, t + 2);
            PG8_WAIT_L(0); PG8_BAR; PG8_MMA(0, 0, At, B0); PG8_MMA(0, 1, At, B1); PG8_BAR; PG8_SCHED;
            PG8_LDA(At, 1, 1); PG8_STAGE(PG8_SB(1, 0), b3, voffB); PG8_STAGE(PG8_SB(1, 1), b3 + hstepB, voffB);
            PG8_WAIT_VR(8, RY); PG8_AWRITE(RY, PG8_SA(0, 0)); if (last) PG8_ALOAD(RY, nO, 0, 1); else PG8_ALOAD(RY, cO, 0, t + 3);
            PG8_WAIT_L(0); PG8_BAR; PG8_MMA(1, 0, At, B0); PG8_MMA(1, 1, At, B1); PG8_BAR; PG8_SCHED;
        }
        if (wr == 0) PG8_BAR;
        E(acc, cur, wr, wc, fr, fq);
        if (!has_next) break;
#pragma unroll
        for (int a = 0; a < 2; ++a)
#pragma unroll
            for (int b = 0; b < 2; ++b)
#pragma unroll
                for (int m = 0; m < 4; ++m)
#pragma unroll
                    for (int n = 0; n < 2; ++n) acc[a][b][m][n] = (f32x4){0.f, 0.f, 0.f, 0.f};
        cur = nxt; cB = nB; ++ui;
#pragma unroll
        for (int _h = 0; _h < 2; ++_h)
#pragma unroll
            for (int _i = 0; _i < 2; ++_i) cO[_h][_i] = nO[_h][_i];
        if (wr == 1) PG8_BAR;
    }
    asm volatile("s_waitcnt vmcnt(0)" : "+v"(RX[0]), "+v"(RX[1]), "+v"(RX[2]), "+v"(RX[3]), "+v"(RY[0]), "+v"(RY[1]), "+v"(RY[2]), "+v"(RY[3]) :: "memory");
    PG8_BAR;
#undef PG8_SA
#undef PG8_SB
#undef PG8_STAGE
#undef PG8_ALOAD
#undef PG8_WAIT_VR
#undef PG8_AWRITE
#undef PG8_LDA
#undef PG8_LDB
#undef PG8_MMA
#undef PG8_WAIT_V
#undef PG8_WAIT_L
#undef PG8_BAR
#undef PG8_SCHED
#undef PG8_AOFFS
}
}
#define XB_TMO      128
#define XB_XCNT(j)  (256  + 64 * (j))
#define XB_XSUB(j)  (1280 + 64 * (j))
#define XB_XGEN(j)  (2304 + 64 * (j))
#define XB_TOP      3328
#define XB_TOPGEN   3392
#define XCD_BAR_WORDS 3456
#define XB_SPIN_CAP (1u << 18)
#define LAS __attribute__((address_space(3)))

__device__ __forceinline__ unsigned xb_ld(unsigned* p)              { return __hip_atomic_load(p, __ATOMIC_RELAXED, __HIP_MEMORY_SCOPE_AGENT); }
__device__ __forceinline__ unsigned xb_add(unsigned* p, unsigned v) { return __hip_atomic_fetch_add(p, v, __ATOMIC_RELAXED, __HIP_MEMORY_SCOPE_AGENT); }
__device__ __forceinline__ unsigned xb_xcc_id() { return (unsigned)__builtin_amdgcn_s_getreg((3 << 11) | 20) & 0xFu; }
#define XB_SPIN(cond, bar) do { unsigned _sp = 0; while (cond) { __builtin_amdgcn_s_sleep(1); \
    if ((++_sp & 255u) == 0u) { if (xb_ld(&(bar)[XB_TMO])) break; if (_sp > XB_SPIN_CAP) { atomicAdd(&(bar)[XB_TMO], 1u); break; } } } } while (0)

__device__ __forceinline__ int xb_lane() { int l; asm volatile("v_mbcnt_lo_u32_b32 %0, -1, 0\n\tv_mbcnt_hi_u32_b32 %0, -1, %0" : "=v"(l)); return l; }
struct XcdBarrier {
    int wave; unsigned* bar; unsigned x;
    volatile LAS unsigned* st;
};

__device__ __forceinline__ XcdBarrier xcd_barrier_post(unsigned* bar, volatile LAS unsigned* st, int wave) {
    XcdBarrier b; b.wave = wave; b.bar = bar; b.x = xb_xcc_id(); b.st = st;
    if (wave == 0 && xb_lane() == 0) (void)xb_add(&bar[XB_XCNT(b.x)], 1u);
    return b;
}
__device__ __forceinline__ void xcd_barrier_complete(unsigned* bar, unsigned x, unsigned& nloc, unsigned& nx) {
    const unsigned G = gridDim.x * gridDim.y * gridDim.z;
    unsigned sum, cnt, mine, sp = 0u;
    for (;;) {
        sum = 0u; cnt = 0u; mine = 0u;
#pragma unroll
        for (unsigned j = 0; j < 16; ++j) { const unsigned c = xb_ld(&bar[XB_XCNT(j)]); sum += c; cnt += (c > 0u) ? 1u : 0u; mine = (j == x) ? c : mine; }
        if (sum == G) break;
        __builtin_amdgcn_s_sleep(1);
        if ((++sp & 255u) == 0u) { if (xb_ld(&bar[XB_TMO])) break; if (sp > XB_SPIN_CAP) { atomicAdd(&bar[XB_TMO], 1u); break; } }
    }
    nloc = mine > 0u ? mine : 1u; nx = cnt > 0u ? cnt : 1u;
}

__device__ __forceinline__ void xcd_barrier(const XcdBarrier& b) {
    asm volatile("s_waitcnt vmcnt(0)" ::: "memory");
    __syncthreads();
    if (b.wave == 0 && xb_lane() == 0) {
        unsigned* bar = b.bar;
        __builtin_amdgcn_s_waitcnt(0);
        unsigned nloc = b.st[0], nx = b.st[1];
        if (nloc == 0u) { xcd_barrier_complete(bar, b.x, nloc, nx); b.st[0] = nloc; b.st[1] = nx; }
        const unsigned old = xb_add(&bar[XB_XSUB(b.x)], 1u);
        const unsigned gen = old / nloc;
        if (old + 1u == (gen + 1u) * nloc) {
            __builtin_amdgcn_fence(__ATOMIC_RELEASE, "agent");
            asm volatile("s_waitcnt vmcnt(0)" ::: "memory");
            const unsigned og = xb_add(&bar[XB_TOP], 1u);
            const unsigned tg = og / nx;
            if (og + 1u == (tg + 1u) * nx) xb_add(&bar[XB_TOPGEN], 1u);
            else XB_SPIN(xb_ld(&bar[XB_TOPGEN]) == tg, bar);
            __builtin_amdgcn_fence(__ATOMIC_ACQUIRE, "agent");
            xb_add(&bar[XB_XGEN(b.x)], 1u);
            asm volatile("s_waitcnt vmcnt(0)" ::: "memory");
        } else {
            XB_SPIN(xb_ld(&bar[XB_XGEN(b.x)]) == gen, bar);
            __builtin_amdgcn_fence(__ATOMIC_ACQUIRE, "agent");
            asm volatile("s_waitcnt vmcnt(0)" ::: "memory");
        }
    }
    __syncthreads();
}

#ifndef MK_DUPF
#define MK_DUPF -1
#endif
namespace mk {
#define DI __device__ __forceinline__
typedef unsigned short bf16_t;
typedef float f32x4 __attribute__((ext_vector_type(4)));
typedef unsigned u32x4 __attribute__((ext_vector_type(4)));
typedef unsigned u32x2 __attribute__((ext_vector_type(2)));

constexpr int D = 2048, NP = 8192, NS = 1024, MT = 9216, TP = 2048, DIN = 6704, DINP = 6912, FF = 5632, FF2 = 11264;
constexpr int NBB = 132;
constexpr int CM = NBB * 4 * 128;
constexpr float EPS = 1e-6f;
constexpr int Z_RQ = 0, Z_RK = 1024, Z_RV = 2048, Z_RG = 3072, Z_NQ = 4096, Z_NKV = 5120, Z_NG = 6656;
constexpr size_t O_Y = 0, O_KV = O_Y + (size_t)MT * D, O_WINP = O_KV + (size_t)MT * 1024, O_WINS = O_WINP + (size_t)4 * 512 * 512,
                 O_RETP = O_WINS + (size_t)128 * 512 * 512, O_RETS = O_RETP + (size_t)16 * 65536, O_CONVP = O_RETS + (size_t)512 * 65536,
                 O_CONVS = O_CONVP + (size_t)4 * 2 * FF2, O_END = O_CONVS + (size_t)128 * 2 * FF2;
constexpr size_t al256(size_t x) { return (x + 255) & ~(size_t)255; }
constexpr size_t WS_CTL = 0, CTL_BYTES = 1u << 20;
constexpr size_t CTL_BAR = 16384;
constexpr size_t CTL_ROWSS = 65536;
constexpr size_t CTL_PAIR = 262144;
constexpr size_t CTL_PEB = 131072;
constexpr size_t WS_W1T = CTL_BYTES;
constexpr size_t WS_W2T = al256(WS_W1T + (size_t)DINP * D * 2);
constexpr size_t WS_W3T = al256(WS_W2T + (size_t)D * D * 2);
constexpr size_t WS_W4T = al256(WS_W3T + (size_t)FF2 * D * 2);
constexpr size_t WS_WC1T = al256(WS_W4T + (size_t)D * FF * 2);
constexpr size_t WS_XG = al256(WS_WC1T + (size_t)1024 * 1024 * 2);
constexpr size_t WS_RSTD1 = al256(WS_XG + (size_t)MT * D * 2);
constexpr size_t WS_SINCOS = al256(WS_RSTD1 + (size_t)MT * 4);
constexpr size_t WS_Z = al256(WS_SINCOS + (size_t)2056 * 128 * 8);
constexpr size_t WS_RQ = al256(WS_Z + (size_t)MT * DINP * 4);
constexpr size_t WS_RK = al256(WS_RQ + (size_t)MT * 1024 * 2);
constexpr size_t WS_RV = al256(WS_RK + (size_t)MT * 1024 * 2);
constexpr size_t WS_NQ = al256(WS_RV + (size_t)MT * 1024 * 2);
constexpr size_t WS_KSLC = al256(WS_NQ + (size_t)MT * 1024 * 2);
constexpr size_t WS_VSLC = al256(WS_KSLC + (size_t)MT * 256 * 2);
constexpr size_t WS_KWIN = al256(WS_VSLC + (size_t)MT * 256 * 2);
constexpr size_t WS_VWIN = al256(WS_KWIN + (size_t)MT * 256 * 2);
constexpr size_t WS_GATES = al256(WS_VWIN + (size_t)MT * 256 * 2);
constexpr size_t WS_CBU = al256(WS_GATES + (size_t)MT * 48 * 4);
constexpr size_t WS_HPRE = al256(WS_CBU + (size_t)2 * CM * 1024 * 2);
constexpr size_t WS_KC = al256(WS_HPRE + (size_t)2 * CM * 512 * 2);
constexpr size_t WS_VC = al256(WS_KC + (size_t)NBB * 4 * 128 * 64 * 2);
constexpr size_t WS_KVC = al256(WS_VC + (size_t)NBB * 4 * 128 * 64 * 2);
constexpr size_t WS_SST = al256(WS_KVC + (size_t)256 * 65536 * 4);
constexpr size_t WS_MIX = al256(WS_SST + (size_t)256 * 65536 * 4);
constexpr size_t WS_H = al256(WS_MIX + (size_t)MT * 2048 * 2);
constexpr size_t WS_HG = al256(WS_H + (size_t)MT * D * 4);
constexpr size_t WS_U = al256(WS_HG + (size_t)MT * D * 2);
constexpr size_t WS_ACT = al256(WS_U + (size_t)MT * FF2 * 2);
constexpr size_t WS_KSP = al256(WS_ACT + (size_t)MT * FF * 2);
constexpr size_t WS_VSPT = al256(WS_KSP + (size_t)16 * 2048 * 64 * 2);
constexpr size_t WS_KWP = al256(WS_VSPT + (size_t)16 * 2048 * 64 * 2);
constexpr size_t WS_VWPT = al256(WS_KWP + (size_t)16 * 2048 * 64 * 2);
constexpr size_t WS_VCT = al256(WS_VWPT + (size_t)16 * 2048 * 64 * 2);
constexpr size_t WS_RGS = al256(WS_VCT + (size_t)NBB * 4 * 64 * 128 * 2);
constexpr size_t WS_NORMS = al256(WS_RGS + (size_t)MT * 1024 * 2);
constexpr size_t WS_SLAB = al256(WS_NORMS + 3 * 64 * 4);
constexpr size_t WS_UX = al256(WS_SLAB + (size_t)8 * NS * D * 4);
constexpr size_t WS_RKT = al256(WS_UX + (size_t)32 * 8 * FF2 * 4);
constexpr size_t WS_RVT = al256(WS_RKT + (size_t)16 * 256 * 2048 * 2);
constexpr size_t WS_KVT = al256(WS_RVT + (size_t)16 * 256 * 2048 * 2);
constexpr size_t WS_SSTT = al256(WS_KVT + (size_t)256 * 65536 * 4);
constexpr size_t WS_END = al256(WS_SSTT + (size_t)256 * 65536 * 2);
static_assert(WS_VSLC - WS_KSLC == (size_t)MT * 512 && WS_KWIN - WS_VSLC == (size_t)MT * 512 && WS_VWIN - WS_KWIN == (size_t)MT * 512, "token-major k/v buffers equally spaced");
static_assert(WS_VSPT - WS_KSP == 4194304 && WS_KWP - WS_VSPT == 4194304 && WS_VWPT - WS_KWP == 4194304, "per-sequence k/v buffers equally spaced");

constexpr int LDS_BYTES = 163840;
constexpr int LDS_MISC = LDS_BYTES - 256;

struct P {
    const float *x_prompt, *x_sample, *cache_kv, *cache_win, *state_ret, *state_conv; const int* page_table;
    const float *g_attn, *w_in, *q_norm, *k_norm_cmp, *k_norm_slc, *k_norm_win, *cmp_pe, *cmp_w1, *cmp_b1, *cmp_w2, *cmp_b2, *ret_gn, *w_out, *g_ffn, *w_up, *conv_w, *conv_b, *w_down;
    float* out; unsigned char* ws; int lo, hi;
};

DI int mk_tid(int wave) { int lane; asm volatile("v_mbcnt_lo_u32_b32 %0, -1, 0\n\tv_mbcnt_hi_u32_b32 %0, -1, %0" : "=v"(lane)); return wave * 64 + lane; }
DI float bf2f(bf16_t b) { return __uint_as_float(((unsigned)b) << 16); }
DI unsigned f2bf(float f) { unsigned u = __float_as_uint(f); return (u + 0x7fffu + ((u >> 16) & 1u)) >> 16; }
DI unsigned pk2(float lo, float hi) { return f2bf(lo) | (f2bf(hi) << 16); }
DI float wave_sum(float v) {
#pragma unroll
    for (int o = 1; o < 64; o <<= 1) v += __shfl_xor(v, o);
    return v; }
DI float wave_max(float v) {
#pragma unroll
    for (int o = 1; o < 64; o <<= 1) v = fmaxf(v, __shfl_xor(v, o));
    return v; }
DI float silu_f(float x) { return x / (1.f + __expf(-x)); }
DI float sigmoid_f(float x) { return 1.f / (1.f + __expf(-x)); }
DI const float* xrow(const P& p, int m) { return m < NP ? p.x_prompt + (size_t)m * D : p.x_sample + (size_t)(m - NP) * D; }
#define LDS_WAIT() asm volatile("s_waitcnt lgkmcnt(0)" ::: "memory")

DI void transpose_item(const float* W, int N, bf16_t* WT, int K, LAS float* scr, int k0, int n0, int lane, int nsrc0 = -1) {
    const int nn = (nsrc0 < 0 ? n0 : nsrc0) + (lane & 31);
    float v[32];
#pragma unroll
    for (int i = 0; i < 32; ++i) { const int kk = 2 * i + (lane >> 5); v[i] = nn < N ? W[(size_t)(k0 + kk) * N + nn] : 0.f; }
#pragma unroll
    for (int i = 0; i < 32; ++i) { const int kk = 2 * i + (lane >> 5); scr[kk * 33 + (lane & 31)] = v[i]; }
    LDS_WAIT();
    const int c = lane & 7;
#pragma unroll
    for (int j = 0; j < 4; ++j) { const int n = (lane >> 3) + 8 * j; const LAS float* s = scr + (8 * c) * 33 + n;
        u32x4 o; o.x = pk2(s[0 * 33], s[1 * 33]); o.y = pk2(s[2 * 33], s[3 * 33]); o.z = pk2(s[4 * 33], s[5 * 33]); o.w = pk2(s[6 * 33], s[7 * 33]);
        *(u32x4*)(WT + (size_t)(n0 + n) * K + k0 + 8 * c) = o; }
    LDS_WAIT();
}


constexpr int CB_P0 = 2048;
DI void phase_cb_convert(const P& p, int bid, int G, int it0, int it1) {
    int tid = mk_tid(p.hi); unsigned char* ws = p.ws;
    {
        bf16_t* CBU = (bf16_t*)(ws + WS_CBU);
        for (int it = it0 + bid; it < it1; it += G) {
            const int b = it >> 4, pi = it & 15, page = p.page_table[b * 16 + pi];
            const float* src = p.cache_kv + (size_t)page * 128 * 1024;
#pragma unroll 1
            for (int q0 = tid; q0 < 128 * 2 * 64; q0 += 512 * 16) {
                f32x4 v[16];
#pragma unroll
                for (int e = 0; e < 16; ++e) { const int q = q0 + 512 * e, r = q >> 7, c = (q >> 6) & 1, f = q & 63; v[e] = *(const f32x4*)(src + (size_t)r * 1024 + c * 256 + f * 4); }
#pragma unroll
                for (int e = 0; e < 16; ++e) { const int q = q0 + 512 * e, r = q >> 7, c = (q >> 6) & 1, f = q & 63, g = f >> 4, d = (f & 15) * 4;
                    u32x2 w; w.x = pk2(v[e].x, v[e].y); w.y = pk2(v[e].z, v[e].w);
                    *(u32x2*)(CBU + ((((size_t)c * NBB + 4 + b) * 4 + g) * 2048 + pi * 128 + r) * 64 + d) = w; }
            }
        }
    }
}
DI void phase_win_copy(const P& p, int bid, int G) {
    int tid = mk_tid(p.hi);
    {
        float* WS_ = p.out + O_WINS;
#pragma unroll 1
        for (int it = bid; it < 128 * 6; it += G) {
            const size_t b = it / 6; const int g0 = (it % 6) * 21; f32x4 v[21];
#pragma unroll
            for (int e = 0; e < 21; ++e) v[e] = __builtin_nontemporal_load((const f32x4*)(p.cache_win + b * 512 * 512 + 8 * 512 + ((size_t)(g0 + e) * 512 + tid) * 4));
#pragma unroll
            for (int e = 0; e < 21; ++e) __builtin_nontemporal_store(v[e], (f32x4*)(WS_ + b * 512 * 512 + ((size_t)(g0 + e) * 512 + tid) * 4));
        }
    }
}

DI void phase_prologue(const P& p, LAS unsigned char* lds, int bid, int G) {
    int tid = mk_tid(p.hi); const int lane = tid & 63, wave = tid >> 6;
    const int gw = bid * 8 + wave, NGW = G * 8;
    unsigned char* ws = p.ws;
    for (int rep = 0; rep < (MK_DUPF == 1 ? 2 : 1); ++rep) {
        LAS float* scr = (LAS float*)(lds + wave * 16384);
        for (int r = gw; r < 32 * 216; r += NGW) { const int n0 = (r % 216) * 32, pn = n0 >> 8; int ns = n0;
            if (pn >= 16 && pn < 26) { const int q = n0 & 255; ns = (n0 & ~255) + 64 * ((q >> 5) & 3) + 32 * (q >> 7); }
            transpose_item(p.w_in, DIN, (bf16_t*)(ws + WS_W1T), D, scr, (r / 216) * 64, n0, lane, ns); }
        for (int r = gw - (NGW >= 1536 ? 1024 : 0); r >= 0 && r < 4 * 128; r += NGW) { const int cj = r / 128, q = r % 128;
            transpose_item(p.cmp_w1 + (size_t)cj * 1024 * 256, 256, (bf16_t*)(ws + WS_WC1T) + (size_t)cj * 256 * 1024, 1024, scr, (q / 8) * 64, (q % 8) * 32, lane); }
    }
    for (int rep = 0; rep < (MK_DUPF == 2 ? 2 : 1); ++rep) {
        bf16_t* XG = (bf16_t*)(ws + WS_XG); float* RSTD = (float*)(ws + WS_RSTD1);
        for (int m = gw; m < MT; m += NGW) {
            const f32x4* xr = (const f32x4*)xrow(p, m) + lane; const f32x4* gr = (const f32x4*)p.g_attn + lane;
            f32x4 v[8]; float s = 0.f;
#pragma unroll
            for (int j = 0; j < 8; ++j) { v[j] = xr[64 * j]; s += (v[j].x * v[j].x + v[j].y * v[j].y) + (v[j].z * v[j].z + v[j].w * v[j].w); }
            s = wave_sum(s);
            if (lane == 0) RSTD[m] = rsqrtf(s * (1.f / D) + EPS);
            u32x2* o = (u32x2*)(XG + (size_t)m * D) + lane;
#pragma unroll
            for (int j = 0; j < 8; ++j) { const f32x4 g = gr[64 * j]; u32x2 w; w.x = pk2(v[j].x * g.x, v[j].y * g.y); w.y = pk2(v[j].z * g.z, v[j].w * g.w); o[64 * j] = w; }
        }
    }
    {
        float2* SC = (float2*)(ws + WS_SINCOS);
        for (int i = bid * 512 + tid; i < 2056 * 128; i += G * 512) {
            const int pos = i >> 7, k = i & 127;
            const double inv = exp(-(double)k * (9.210340371976184 / 127.0));
            double rev = (double)pos * inv * 0.15915494309189535; rev -= floor(rev);
            const float rf = (float)rev;
            SC[i] = make_float2(__builtin_amdgcn_cosf(rf), __builtin_amdgcn_sinf(rf));
        }
    }
    if (bid == 0 && tid < 192) ((float*)(ws + WS_NORMS))[tid] = tid < 64 ? p.q_norm[tid] : (tid < 128 ? p.k_norm_slc[tid - 64] : p.k_norm_win[tid - 128]);
    if (bid < 32) {
        const int c = bid >> 4, k0 = (bid & 15) * 128, h = tid & 255, half = tid >> 8;
        float s = 0.f;
        for (int k = k0 + half * 64; k < k0 + half * 64 + 64; ++k) s += p.cmp_pe[c * 2048 + k] * p.cmp_w1[((size_t)c * 2048 + k) * 256 + h];
        atomicAdd((float*)(ws + CTL_PEB) + c * 256 + h, s);
    }
}


constexpr int I1 = 32 * 64, I2 = 32 * 352, I3 = 88 * 64;
DI void slice_one(const P& p, LAS float* scr, int r, int lane) {
    unsigned char* ws = p.ws;
    if (r < I1) { transpose_item(p.w_out, D, (bf16_t*)(ws + WS_W2T), D, scr, (r / 64) * 64, (r % 64) * 32, lane); return; } r -= I1;
    if (r < I2) { const int n0 = (r % 352) * 32; transpose_item(p.w_up, FF2, (bf16_t*)(ws + WS_W3T), D, scr, (r / 352) * 64, n0, lane, ((n0 >> 7) & 1) * FF + 128 * (n0 >> 8) + (n0 & 127)); return; } r -= I2;
    transpose_item(p.w_down, D, (bf16_t*)(ws + WS_W4T), FF, scr, (r / 64) * 64, (r % 64) * 32, lane);
}
DI void phase_slice(const P& p, LAS unsigned char* lds, int bid, int G, int it0, int it1) {
    int tid = mk_tid(p.hi);
    const int lane = tid & 63, wave = __builtin_amdgcn_readfirstlane(tid >> 6); const int gw = bid * 8 + wave, NGW = G * 8; unsigned char* ws = p.ws;
    LAS float* scr = (LAS float*)(lds + wave * 16384);
    const int e1 = it1 < I1 ? it1 : I1, s2 = it0 > I1 ? it0 : I1, e2 = it1 < I1 + I2 ? it1 : I1 + I2, s3 = it0 > I1 + I2 ? it0 : I1 + I2;
    for (int it = it0 + gw; it < e1; it += NGW) slice_one(p, scr, it, lane);
    {
        auto wup_load = [&](float (&v)[32], int r) { r -= I1; const int n0 = (r % 352) * 32, k0 = (r / 352) * 64, nn = ((n0 >> 7) & 1) * FF + 128 * (n0 >> 8) + (n0 & 127) + (lane & 31);
#pragma unroll
            for (int i = 0; i < 32; ++i) v[i] = p.w_up[(size_t)(k0 + 2 * i + (lane >> 5)) * FF2 + nn]; };
        auto wup_finish = [&](const float (&v)[32], int r) { r -= I1; const int n0 = (r % 352) * 32, k0 = (r / 352) * 64; bf16_t* WT = (bf16_t*)(ws + WS_W3T);
#pragma unroll
            for (int i = 0; i < 32; ++i) scr[(2 * i + (lane >> 5)) * 33 + (lane & 31)] = v[i];
            LDS_WAIT();
            const int c = lane & 7;
#pragma unroll
            for (int j = 0; j < 4; ++j) { const int n = (lane >> 3) + 8 * j; const LAS float* s = scr + (8 * c) * 33 + n;
                u32x4 o; o.x = pk2(s[0 * 33], s[1 * 33]); o.y = pk2(s[2 * 33], s[3 * 33]); o.z = pk2(s[4 * 33], s[5 * 33]); o.w = pk2(s[6 * 33], s[7 * 33]);
                *(u32x4*)(WT + (size_t)(n0 + n) * D + k0 + 8 * c) = o; }
            LDS_WAIT(); };
        int it = s2 + gw; bool have = it < e2; float v[32];
        if (have) wup_load(v, it);
        while (have) { const int nx = it + NGW; const bool hn = nx < e2; float w[32];
            if (hn) wup_load(w, nx);
            asm volatile("" ::: "memory");
            wup_finish(v, it);
#pragma unroll
            for (int i = 0; i < 32; ++i) v[i] = w[i];
            it = nx; have = hn; }
    }
    for (int it = s3 + gw; it < it1; it += NGW) slice_one(p, scr, it, lane);
}
DI void phase_post(const P& p, LAS unsigned char* lds, int bid, int G) {
    int tid = mk_tid(p.hi); const int lane = tid & 63, wave = tid >> 6;
    unsigned char* ws = p.ws;
    const float* Z = (const float*)(ws + WS_Z); const float2* SC = (const float2*)(ws + WS_SINCOS);
    bf16_t *RQ = (bf16_t*)(ws + WS_RQ), *RK = (bf16_t*)(ws + WS_RK), *RV = (bf16_t*)(ws + WS_RV), *NQ = (bf16_t*)(ws + WS_NQ);
    bf16_t *KSLC = (bf16_t*)(ws + WS_KSLC), *VSLC = (bf16_t*)(ws + WS_VSLC), *KWIN = (bf16_t*)(ws + WS_KWIN), *VWIN = (bf16_t*)(ws + WS_VWIN), *CBU = (bf16_t*)(ws + WS_CBU);
    float* GATES = (float*)(ws + WS_GATES);
    bf16_t *KSP = (bf16_t*)(ws + WS_KSP), *VSPT = (bf16_t*)(ws + WS_VSPT), *KWP = (bf16_t*)(ws + WS_KWP), *VWPT = (bf16_t*)(ws + WS_VWPT);
    for (int m = bid; m < MT; m += G) {
        const float* zr = Z + (size_t)m * DINP;
        const bool prompt = m < NP; const int b = prompt ? (m >> 11) : ((m - NP) >> 3), t = prompt ? (m & 2047) : ((m - NP) & 7), pos = prompt ? t : 2048 + t;
        { const int hh = tid >> 7, ii = tid & 127; const float2 cs = SC[pos * 128 + ii];
#pragma unroll
          for (int w = 0; w < 2; ++w) { const float x1 = zr[w * 1024 + hh * 256 + ii], x2 = zr[w * 1024 + hh * 256 + 128 + ii]; const float sc = w ? 0.0625f : 1.f;
              bf16_t* dst = (w ? RK : RQ) + (size_t)m * 1024 + hh * 256 + ii;
              dst[0] = (bf16_t)f2bf((x1 * cs.x - x2 * cs.y) * sc); dst[128] = (bf16_t)f2bf((x2 * cs.x + x1 * cs.y) * sc); } }
        RV[(size_t)m * 1024 + tid] = (bf16_t)f2bf(zr[Z_RV + tid]); RV[(size_t)m * 1024 + 512 + tid] = (bf16_t)f2bf(zr[Z_RV + 512 + tid]);
#pragma unroll
        for (int q = 0; q < 2; ++q) { const int hd = 2 * wave + q; const float v = zr[Z_NQ + hd * 64 + lane]; const float r = rsqrtf(wave_sum(v * v) * (1.f / 64.f) + EPS);
            NQ[(size_t)m * 1024 + hd * 64 + lane] = (bf16_t)f2bf(v * r * p.q_norm[lane] * 0.125f); }
#pragma unroll
        for (int q = 0; q < 3; ++q) { const int vi = wave + 8 * q, s = vi >> 2, g = vi & 3; float v = zr[Z_NKV + vi * 64 + lane];
            if (s == 2 || s == 4) { const float r = rsqrtf(wave_sum(v * v) * (1.f / 64.f) + EPS); v = v * r * (s == 2 ? p.k_norm_slc[lane] : p.k_norm_win[lane]); }
            if (s < 4) { p.out[O_KV + (size_t)m * 1024 + s * 256 + g * 64 + lane] = v;
                if (s < 2) { if (prompt) CBU[((((size_t)s * NBB + b) * 4 + g) * 2048 + t) * 64 + lane] = (bf16_t)f2bf(v); }
                else { (s == 2 ? KSLC : VSLC)[(size_t)m * 256 + g * 64 + lane] = (bf16_t)f2bf(v);
                    if (prompt) { if (s == 2) KSP[(((size_t)b * 4 + g) * 2048 + t) * 64 + lane] = (bf16_t)f2bf(v); else VSPT[(((size_t)b * 4 + g) * 64 + lane) * 2048 + t] = (bf16_t)f2bf(v); } }
            } else { (s == 4 ? KWIN : VWIN)[(size_t)m * 256 + g * 64 + lane] = (bf16_t)f2bf(v);
                if (prompt) { if (s == 4) KWP[(((size_t)b * 4 + g) * 2048 + t) * 64 + lane] = (bf16_t)f2bf(v); else VWPT[(((size_t)b * 4 + g) * 64 + lane) * 2048 + t] = (bf16_t)f2bf(v); }
                if (prompt) { if (t >= 1536) p.out[O_WINP + (((size_t)b * 512 + (t - 1536)) * 2 + (s - 4)) * 256 + g * 64 + lane] = v; }
                else p.out[O_WINS + (((size_t)b * 512 + 504 + t) * 2 + (s - 4)) * 256 + g * 64 + lane] = v; } }
        if (tid < 48) GATES[(size_t)m * 48 + tid] = sigmoid_f(zr[Z_NG + tid]);
    }
}


DI void load8(const bf16_t* p, float (&v)[8]) { const u32x4 r = *(const u32x4*)p; v[0] = __uint_as_float(r.x << 16); v[1] = __uint_as_float(r.x & 0xffff0000u); v[2] = __uint_as_float(r.y << 16); v[3] = __uint_as_float(r.y & 0xffff0000u);
    v[4] = __uint_as_float(r.z << 16); v[5] = __uint_as_float(r.z & 0xffff0000u); v[6] = __uint_as_float(r.w << 16); v[7] = __uint_as_float(r.w & 0xffff0000u); }
DI void load8(const float* p, float (&v)[8]) { const f32x4 a = *(const f32x4*)p, b = *(const f32x4*)(p + 4); v[0] = a.x; v[1] = a.y; v[2] = a.z; v[3] = a.w; v[4] = b.x; v[5] = b.y; v[6] = b.z; v[7] = b.w; }
DI float gamma_log2(int h) { return log2f(1.f - exp2f(-5.f - (float)h)); }

DI void phase_ret_kv(const P& p, LAS unsigned char* lds, int bid, int G) {
    int tid = mk_tid(p.hi); unsigned char* ws = p.ws;
    const bf16_t *RK = (const bf16_t*)(ws + WS_RK), *RV = (const bf16_t*)(ws + WS_RV); float* KVC = (float*)(ws + WS_KVC);
    LAS float* ks = (LAS float*)lds; LAS float* vs = ks + 32 * 256;
    const int ty = tid >> 5, tx = tid & 31;
    for (int unit = bid; unit < 256; unit += G) {
        const int b = unit >> 6, h = (unit >> 4) & 3, c = unit & 15; const float lg = gamma_log2(h);
        float acc[16][8];
#pragma unroll
        for (int a = 0; a < 16; ++a)
#pragma unroll
            for (int e = 0; e < 8; ++e) acc[a][e] = 0.f;
        for (int jc = 0; jc < 4; ++jc) {
            __syncthreads();
#pragma unroll 4
            for (int i = 0; i < 16; ++i) { const int idx = tid + 512 * i, j = idx >> 8, dc = idx & 255; const size_t m = (size_t)b * 2048 + c * 128 + jc * 32 + j;
                ks[idx] = bf2f(RK[m * 1024 + h * 256 + dc]) * exp2f(lg * (float)(127 - (jc * 32 + j))); vs[idx] = bf2f(RV[m * 1024 + h * 256 + dc]); }
            __syncthreads();
            for (int j = 0; j < 32; ++j) {
                f32x4 kr[4], vr[2];
#pragma unroll
                for (int q = 0; q < 4; ++q) kr[q] = *(const LAS f32x4*)(ks + j * 256 + ty * 16 + q * 4);
#pragma unroll
                for (int q = 0; q < 2; ++q) vr[q] = *(const LAS f32x4*)(vs + j * 256 + tx * 8 + q * 4);
#pragma unroll
                for (int a = 0; a < 16; ++a)
#pragma unroll
                    for (int e = 0; e < 8; ++e) acc[a][e] += kr[a >> 2][a & 3] * vr[e >> 2][e & 3];
            }
        }
        float* o = KVC + (size_t)unit * 65536;
#pragma unroll
        for (int a = 0; a < 16; ++a) { *(f32x4*)(o + (ty * 16 + a) * 256 + tx * 8) = (f32x4){acc[a][0], acc[a][1], acc[a][2], acc[a][3]}; *(f32x4*)(o + (ty * 16 + a) * 256 + tx * 8 + 4) = (f32x4){acc[a][4], acc[a][5], acc[a][6], acc[a][7]}; }
    }
}

DI void phase_ret_scan(const P& p, int bid, int G) {
    int tid = mk_tid(p.hi); unsigned char* ws = p.ws;
    const float* KVC = (const float*)(ws + WS_KVC); float* SST = (float*)(ws + WS_SST);
    for (int i = bid * 512 + tid; i < 16 * 16384; i += G * 512) {
        const int bh = i >> 14, e = (i & 16383) * 4; const float gc = exp2f(gamma_log2(bh & 3) * 128.f);
        f32x4 S = (f32x4){0.f, 0.f, 0.f, 0.f}, kv[16];
#pragma unroll
        for (int c = 0; c < 16; ++c) kv[c] = *(const f32x4*)(KVC + ((size_t)bh * 16 + c) * 65536 + e);
#pragma unroll
        for (int c = 0; c < 16; ++c) { *(f32x4*)(SST + ((size_t)bh * 16 + c) * 65536 + e) = S; S = S * gc + kv[c]; }
        *(f32x4*)(p.out + O_RETP + (size_t)bh * 65536 + e) = S;
    }
}

DI void phase_ret_out(const P& p, LAS unsigned char* lds, int bid, int G) {
    int tid = mk_tid(p.hi); unsigned char* ws = p.ws;
    const bf16_t *RQ = (const bf16_t*)(ws + WS_RQ), *RK = (const bf16_t*)(ws + WS_RK), *RV = (const bf16_t*)(ws + WS_RV);
    const float* SST = (const float*)(ws + WS_SST); const bf16_t* RGS = (const bf16_t*)(ws + WS_RGS); bf16_t* MIX = (bf16_t*)(ws + WS_MIX);
    LAS float* As = (LAS float*)lds;
    LAS float* R1 = As + 128 * 129;
    for (int unit = bid; unit < 256; unit += G) {
        const int b = unit >> 6, h = (unit >> 4) & 3, c = unit & 15; const float lg = gamma_log2(h);
        const size_t m0 = (size_t)b * 2048 + c * 128;
        {
            LAS float* qs = R1; LAS float* ks = R1 + 128 * 65;
            const int ty = tid >> 4, tx = tid & 15;
            float acc[4][8];
#pragma unroll
            for (int a = 0; a < 4; ++a)
#pragma unroll
                for (int e = 0; e < 8; ++e) acc[a][e] = 0.f;
            for (int dc = 0; dc < 4; ++dc) {
                __syncthreads();
#pragma unroll 4
                for (int i = 0; i < 16; ++i) { const int idx = tid + 512 * i, r = idx >> 6, d = idx & 63;
                    qs[r * 65 + d] = bf2f(RQ[(m0 + r) * 1024 + h * 256 + dc * 64 + d]); ks[r * 65 + d] = bf2f(RK[(m0 + r) * 1024 + h * 256 + dc * 64 + d]); }
                __syncthreads();
                for (int d = 0; d < 64; ++d) {
                    float qv[4], kv[8];
#pragma unroll
                    for (int a = 0; a < 4; ++a) qv[a] = qs[(ty * 4 + a) * 65 + d];
#pragma unroll
                    for (int e = 0; e < 8; ++e) kv[e] = ks[(tx * 8 + e) * 65 + d];
#pragma unroll
                    for (int a = 0; a < 4; ++a)
#pragma unroll
                        for (int e = 0; e < 8; ++e) acc[a][e] += qv[a] * kv[e];
                }
            }
#pragma unroll
            for (int a = 0; a < 4; ++a)
#pragma unroll
                for (int e = 0; e < 8; ++e) { const int i = ty * 4 + a, j = tx * 8 + e; As[i * 129 + j] = (j <= i) ? acc[a][e] * exp2f(lg * (float)(i - j)) : 0.f; }
        }
        const int ty = tid >> 5, tx = tid & 31;
        float o[8][8];
#pragma unroll
        for (int a = 0; a < 8; ++a)
#pragma unroll
            for (int e = 0; e < 8; ++e) o[a][e] = 0.f;
        LAS float* bs = R1; LAS float* qc = R1 + 32 * 256;
        for (int jc = 0; jc < 4; ++jc) {
            __syncthreads();
#pragma unroll 4
            for (int i = 0; i < 16; ++i) { const int idx = tid + 512 * i, j = idx >> 8, e = idx & 255; bs[idx] = bf2f(RV[(m0 + jc * 32 + j) * 1024 + h * 256 + e]); }
            __syncthreads();
            for (int j = 0; j < 32; ++j) {
                float av[8]; f32x4 vr[2];
#pragma unroll
                for (int a = 0; a < 8; ++a) av[a] = As[(ty * 8 + a) * 129 + jc * 32 + j];
                vr[0] = *(const LAS f32x4*)(bs + j * 256 + tx * 8); vr[1] = *(const LAS f32x4*)(bs + j * 256 + tx * 8 + 4);
#pragma unroll
                for (int a = 0; a < 8; ++a)
#pragma unroll
                    for (int e = 0; e < 8; ++e) o[a][e] += av[a] * vr[e >> 2][e & 3];
            }
        }
        const float* S = SST + (size_t)unit * 65536;
        for (int dc = 0; dc < 8; ++dc) {
            __syncthreads();
#pragma unroll 4
            for (int i = 0; i < 16; ++i) { const int idx = tid + 512 * i, j = idx >> 8, e = idx & 255; bs[idx] = S[(dc * 32 + j) * 256 + e]; }
#pragma unroll 4
            for (int i = 0; i < 8; ++i) { const int idx = tid + 512 * i, r = idx >> 5, d = idx & 31; qc[r * 33 + d] = bf2f(RQ[(m0 + r) * 1024 + h * 256 + dc * 32 + d]) * exp2f(lg * (float)(r + 1)); }
            __syncthreads();
            for (int j = 0; j < 32; ++j) {
                float av[8]; f32x4 vr[2];
#pragma unroll
                for (int a = 0; a < 8; ++a) av[a] = qc[(ty * 8 + a) * 33 + j];
                vr[0] = *(const LAS f32x4*)(bs + j * 256 + tx * 8); vr[1] = *(const LAS f32x4*)(bs + j * 256 + tx * 8 + 4);
#pragma unroll
                for (int a = 0; a < 8; ++a)
#pragma unroll
                    for (int e = 0; e < 8; ++e) o[a][e] += av[a] * vr[e >> 2][e & 3];
            }
        }
#pragma unroll
        for (int a = 0; a < 8; ++a) {
            float ss = 0.f;
#pragma unroll
            for (int e = 0; e < 8; ++e) ss += o[a][e] * o[a][e];
#pragma unroll
            for (int q = 1; q < 32; q <<= 1) ss += __shfl_xor(ss, q);
            const float r = rsqrtf(ss * (1.f / 256.f) + EPS); const size_t m = m0 + ty * 8 + a;
            float rgv[8]; load8(RGS + m * 1024 + h * 256 + tx * 8, rgv); const float* gn = p.ret_gn + h * 256 + tx * 8;
            u32x4 w; float y[8];
#pragma unroll
            for (int e = 0; e < 8; ++e) y[e] = o[a][e] * r * gn[e] * rgv[e];
            w.x = pk2(y[0], y[1]); w.y = pk2(y[2], y[3]); w.z = pk2(y[4], y[5]); w.w = pk2(y[6], y[7]);
            *(u32x4*)(MIX + m * 2048 + h * 256 + tx * 8) = w;
        }
        __syncthreads();
    }
}

DI void ret_sample_wave(const P& p, LAS unsigned char* scr, int unit, int lane) {
    unsigned char* ws = p.ws;
    const bf16_t *RQ = (const bf16_t*)(ws + WS_RQ), *RK = (const bf16_t*)(ws + WS_RK), *RV = (const bf16_t*)(ws + WS_RV), *RGS = (const bf16_t*)(ws + WS_RGS); bf16_t* MIX = (bf16_t*)(ws + WS_MIX);
    LAS bf16_t* qk = (LAS bf16_t*)scr; LAS float* am = (LAS float*)(scr + 8192);
    const int b = unit >> 2, h = unit & 3; const size_t m0 = NP + (size_t)b * 8; const float g8 = exp2f(gamma_log2(h) * 8.f);
    f32x4 vreg[8];
    {   f32x4 q4[8], k4[8];
#pragma unroll
        for (int t = 0; t < 8; ++t) { const size_t o = (m0 + t) * 1024 + h * 256 + lane * 4;
            const u32x2 qw = *(const u32x2*)(RQ + o), kw = *(const u32x2*)(RK + o), vw = *(const u32x2*)(RV + o);
            q4[t] = (f32x4){__uint_as_float(qw.x << 16), __uint_as_float(qw.x & 0xffff0000u), __uint_as_float(qw.y << 16), __uint_as_float(qw.y & 0xffff0000u)};
            k4[t] = (f32x4){__uint_as_float(kw.x << 16), __uint_as_float(kw.x & 0xffff0000u), __uint_as_float(kw.y << 16), __uint_as_float(kw.y & 0xffff0000u)};
            vreg[t] = (f32x4){__uint_as_float(vw.x << 16), __uint_as_float(vw.x & 0xffff0000u), __uint_as_float(vw.y << 16), __uint_as_float(vw.y & 0xffff0000u)};
            LAS bf16_t* row = qk + (lane * 4) * 16 + t;
            row[0] = (bf16_t)(qw.x & 0xffffu); row[16] = (bf16_t)(qw.x >> 16); row[32] = (bf16_t)(qw.y & 0xffffu); row[48] = (bf16_t)(qw.y >> 16);
            row[8] = (bf16_t)(kw.x & 0xffffu); row[24] = (bf16_t)(kw.x >> 16); row[40] = (bf16_t)(kw.y & 0xffffu); row[56] = (bf16_t)(kw.y >> 16); }
#pragma unroll
        for (int t = 0; t < 8; ++t)
#pragma unroll
            for (int j = 0; j < 8; ++j) { float a = 0.f;
                if (j <= t) { const f32x4 pr = q4[t] * k4[j]; a = wave_sum((pr[0] + pr[1]) + (pr[2] + pr[3])); }
                if (lane == 0) am[t * 8 + j] = a; }
    }
    LDS_WAIT();
    f32x4 oacc[8];
#pragma unroll
    for (int t = 0; t < 8; ++t) oacc[t] = (f32x4){0.f, 0.f, 0.f, 0.f};
    const float* S0 = p.state_ret + (size_t)unit * 65536; float* Sn = p.out + O_RETS + (size_t)unit * 65536;
    f32x4 bA[8], bB[8], bC[8];
    auto ld = [&](f32x4 (&buf)[8], int d0) {
#pragma unroll
        for (int e = 0; e < 8; ++e) buf[e] = __builtin_nontemporal_load((const f32x4*)(S0 + (d0 + e) * 256 + lane * 4));
        asm volatile("" ::: "memory"); };
    auto use = [&](const f32x4 (&buf)[8], int d0) {
#pragma unroll
        for (int e = 0; e < 8; ++e) { const int d = d0 + e;
            const u32x4 wq = *(const LAS u32x4*)(qk + d * 16), wk = *(const LAS u32x4*)(qk + d * 16 + 8);
            f32x4 sn = buf[e];
#pragma unroll
            for (int i = 0; i < 4; ++i) { const float q0 = __uint_as_float(wq[i] << 16), q1 = __uint_as_float(wq[i] & 0xffff0000u), k0 = __uint_as_float(wk[i] << 16), k1 = __uint_as_float(wk[i] & 0xffff0000u);
                oacc[2 * i] += buf[e] * q0; oacc[2 * i + 1] += buf[e] * q1; sn += vreg[2 * i] * k0; sn += vreg[2 * i + 1] * k1; }
            __builtin_nontemporal_store(sn * g8, (f32x4*)(Sn + d * 256 + lane * 4)); }
        asm volatile("" ::: "memory"); };
    ld(bA, 0); ld(bB, 8);
#pragma unroll 1
    for (int d0 = 0; d0 < 240; d0 += 24) {
        ld(bC, d0 + 16); use(bA, d0);
        ld(bA, d0 + 24); use(bB, d0 + 8);
        ld(bB, d0 + 32); use(bC, d0 + 16);
    }
    use(bA, 240); use(bB, 248);
#pragma unroll
    for (int t = 0; t < 8; ++t) { f32x4 o = oacc[t];
#pragma unroll
        for (int j = 0; j <= t; ++j) o += vreg[j] * am[t * 8 + j];
        const float ss = wave_sum((o.x * o.x + o.y * o.y) + (o.z * o.z + o.w * o.w)); const float r = rsqrtf(ss * (1.f / 256.f) + EPS);
        const size_t m = m0 + t; const u32x2 rgb = *(const u32x2*)(RGS + m * 1024 + h * 256 + lane * 4); const f32x4 gn = *(const f32x4*)(p.ret_gn + h * 256 + lane * 4);
        const f32x4 rg = (f32x4){__uint_as_float(rgb.x << 16), __uint_as_float(rgb.x & 0xffff0000u), __uint_as_float(rgb.y << 16), __uint_as_float(rgb.y & 0xffff0000u)};
        u32x2 w; w.x = pk2(o.x * r * gn.x * rg.x, o.y * r * gn.y * rg.y); w.y = pk2(o.z * r * gn.z * rg.z, o.w * r * gn.w * rg.w);
        *(u32x2*)(MIX + m * 2048 + h * 256 + lane * 4) = w; }
}
DI void phase_ret_sample(const P& p, LAS unsigned char* lds, int bid, int G) {
    int tid = mk_tid(p.hi); const int lane = tid & 63, wave = tid >> 6; unsigned char* ws = p.ws;
    const bf16_t *RQ = (const bf16_t*)(ws + WS_RQ), *RK = (const bf16_t*)(ws + WS_RK), *RV = (const bf16_t*)(ws + WS_RV);
    const bf16_t* RGS = (const bf16_t*)(ws + WS_RGS); bf16_t* MIX = (bf16_t*)(ws + WS_MIX);
    LAS float* qs = (LAS float*)lds; LAS float* ks = qs + 2048; LAS float* kraw = ks + 2048; LAS float* vs = kraw + 2048; LAS float* Am = vs + 2048; LAS float* red = Am + 64;
    for (int unit = bid; unit < 512; unit += G) {
        const int b = unit >> 2, h = unit & 3; const float lg = gamma_log2(h); const size_t m0 = NP + (size_t)b * 8;
        __syncthreads();
        for (int i = tid; i < 2048; i += 512) { const int t = i >> 8, d = i & 255; const size_t o = (m0 + t) * 1024 + h * 256 + d;
            const float kv = bf2f(RK[o]); qs[i] = bf2f(RQ[o]); kraw[i] = kv; ks[i] = kv; vs[i] = bf2f(RV[o]); }
        __syncthreads();
        { const int t = wave;
#pragma unroll
          for (int j = 0; j < 8; ++j) { float s = 0.f;
#pragma unroll
              for (int q = 0; q < 4; ++q) s += qs[t * 256 + lane + 64 * q] * kraw[j * 256 + lane + 64 * q];
              s = wave_sum(s); if (lane == 0) Am[t * 8 + j] = (j <= t) ? s : 0.f; } }
        f32x4 vreg[8], oacc[8];
#pragma unroll
        for (int t = 0; t < 8; ++t) { vreg[t] = *(const LAS f32x4*)(vs + t * 256 + lane * 4); oacc[t] = (f32x4){0.f, 0.f, 0.f, 0.f}; }
        const float g8 = exp2f(lg * 8.f);
        const float* S0 = p.state_ret + (size_t)unit * 65536; float* Sn = p.out + O_RETS + (size_t)unit * 65536;
        f32x4 cur[8], nxt[8];
#pragma unroll
        for (int e = 0; e < 8; ++e) cur[e] = __builtin_nontemporal_load((const f32x4*)(S0 + (wave * 32 + e) * 256 + lane * 4));
#pragma unroll 1
        for (int d0 = wave * 32; d0 < wave * 32 + 32; d0 += 8) {
            const int dn = (d0 + 8 < wave * 32 + 32) ? d0 + 8 : d0;
#pragma unroll
            for (int e = 0; e < 8; ++e) nxt[e] = __builtin_nontemporal_load((const f32x4*)(S0 + (dn + e) * 256 + lane * 4));
            asm volatile("" ::: "memory");
#pragma unroll
            for (int e = 0; e < 8; ++e) { const int d = d0 + e; f32x4 sn = cur[e];
#pragma unroll
                for (int t = 0; t < 8; ++t) { oacc[t] += cur[e] * qs[t * 256 + d]; sn += vreg[t] * ks[t * 256 + d]; }
                __builtin_nontemporal_store(sn * g8, (f32x4*)(Sn + d * 256 + lane * 4)); }
            asm volatile("" ::: "memory");
#pragma unroll
            for (int e = 0; e < 8; ++e) cur[e] = nxt[e];
        }
#pragma unroll
        for (int t = 0; t < 8; ++t) *(LAS f32x4*)(red + (wave * 8 + t) * 256 + lane * 4) = oacc[t];
        __syncthreads();
        { const int t = wave; f32x4 o = (f32x4){0.f, 0.f, 0.f, 0.f};
#pragma unroll
          for (int w = 0; w < 8; ++w) o += *(const LAS f32x4*)(red + (w * 8 + t) * 256 + lane * 4);
#pragma unroll
          for (int j = 0; j < 8; ++j) o += vreg[j] * Am[t * 8 + j];
          const float ss = wave_sum((o.x * o.x + o.y * o.y) + (o.z * o.z + o.w * o.w)); const float r = rsqrtf(ss * (1.f / 256.f) + EPS);
          const size_t m = m0 + t; const u32x2 rgb = *(const u32x2*)(RGS + m * 1024 + h * 256 + lane * 4); const f32x4 gn = *(const f32x4*)(p.ret_gn + h * 256 + lane * 4);
          const f32x4 rg = (f32x4){__uint_as_float(rgb.x << 16), __uint_as_float(rgb.x & 0xffff0000u), __uint_as_float(rgb.y << 16), __uint_as_float(rgb.y & 0xffff0000u)};
          u32x2 w; w.x = pk2(o.x * r * gn.x * rg.x, o.y * r * gn.y * rg.y); w.y = pk2(o.z * r * gn.z * rg.z, o.w * r * gn.w * rg.w);
          *(u32x2*)(MIX + m * 2048 + h * 256 + lane * 4) = w; }
    }
}

DI void phase_cmp_l2(const P& p, LAS unsigned char* lds, int bid, int G) {
    int tid = mk_tid(p.hi); const int lane = tid & 63, wave = tid >> 6; unsigned char* ws = p.ws;
    const bf16_t* HPRE = (const bf16_t*)(ws + WS_HPRE); const float* PEB = (const float*)(ws + CTL_PEB);
    bf16_t *KC = (bf16_t*)(ws + WS_KC), *VC = (bf16_t*)(ws + WS_VC), *VCT = (bf16_t*)(ws + WS_VCT);
    LAS float* hid = (LAS float*)lds + wave * 256;
    const int gw = bid * 8 + wave, NGW = G * 8;
    for (int task = gw; task < 2 * NBB * 4 * 128; task += NGW) {
        const int c = task / (NBB * 512), rem = task % (NBB * 512), i = rem & 127; const size_t row = rem;
        bf16_t* dst = (c ? VC : KC) + row * 64 + lane;
        bf16_t* dstT = VCT + ((row >> 7) * 64 + lane) * 128 + i;
        if (i == 127) { *dst = 0; if (c) *dstT = 0; continue; }
        const bf16_t* h0 = HPRE + ((size_t)c * CM + row) * 512; const bf16_t* h1 = h0 + 512 + 256;
#pragma unroll
        for (int q = 0; q < 4; ++q) { const int hh = lane + 64 * q; hid[hh] = silu_f(bf2f(h0[hh]) + bf2f(h1[hh]) + PEB[c * 256 + hh] + p.cmp_b1[c * 256 + hh]); }
        LDS_WAIT();
        const float* w2 = p.cmp_w2 + (size_t)c * 256 * 64 + lane; float acc = p.cmp_b2[c * 64 + lane];
#pragma unroll 8
        for (int hh = 0; hh < 256; ++hh) acc += hid[hh] * w2[hh * 64];
        if (c == 0) { const float r = rsqrtf(wave_sum(acc * acc) * (1.f / 64.f) + EPS); acc = acc * r * p.k_norm_cmp[lane]; }
        *dst = (bf16_t)f2bf(acc); if (c) *dstT = (bf16_t)f2bf(acc);
        LDS_WAIT();
    }
}

DI float ld_elem(const bf16_t* p) { return bf2f(*p); }
DI float ld_elem(const float* p) { return *p; }

template <class T> DI void dot4_row(const LAS float* qs, const T* kr, float (&s)[4]) {
#pragma unroll 1
    for (int d8 = 0; d8 < 8; ++d8) { float kv[8]; load8(kr + d8 * 8, kv); asm volatile("" ::: "memory");
#pragma unroll
        for (int r = 0; r < 4; ++r) { const f32x4 qa = *(const LAS f32x4*)(qs + r * 64 + d8 * 8), qb = *(const LAS f32x4*)(qs + r * 64 + d8 * 8 + 4);
            s[r] += (qa.x * kv[0] + qa.y * kv[1]) + (qa.z * kv[2] + qa.w * kv[3]) + (qb.x * kv[4] + qb.y * kv[5]) + (qb.z * kv[6] + qb.w * kv[7]); } }
}
struct AttnState { float m[4], l[4], o[4]; };
template <class T> DI void attend_chunk(AttnState& st, const LAS float* qs, LAS float* ps, const T* kbase, const T* vbase, int stride, int nkeys, int dist0, int dstep, int maxdist, const float (&slope)[4], int lane) {
    const int dist = dist0 - lane * dstep; const bool valid = lane < nkeys && dist >= 0 && dist < maxdist;
    float s[4] = {0.f, 0.f, 0.f, 0.f};
    if (valid) dot4_row<T>(qs, kbase + (size_t)lane * stride, s);
    float pr[4];
#pragma unroll
    for (int r = 0; r < 4; ++r) { const float sc = valid ? s[r] - slope[r] * (float)dist : -INFINITY; const float cm = wave_max(sc); const float mn = fmaxf(st.m[r], cm);
        const float alpha = (mn == -INFINITY) ? 1.f : __expf(st.m[r] - mn); pr[r] = valid ? __expf(sc - mn) : 0.f;
        st.l[r] = st.l[r] * alpha + wave_sum(pr[r]); st.o[r] *= alpha; st.m[r] = mn; }
    *(LAS f32x4*)(ps + lane * 4) = (f32x4){pr[0], pr[1], pr[2], pr[3]};
    LDS_WAIT();
#pragma unroll 4
    for (int kk = 0; kk < nkeys; ++kk) { const float v = ld_elem(vbase + (size_t)kk * stride + lane); const f32x4 pv = *(const LAS f32x4*)(ps + kk * 4);
        st.o[0] += pv.x * v; st.o[1] += pv.y * v; st.o[2] += pv.z * v; st.o[3] += pv.w * v; }
    LDS_WAIT();
}
DI void attn_reset(AttnState& st) {
#pragma unroll
    for (int r = 0; r < 4; ++r) { st.m[r] = -INFINITY; st.l[r] = 0.f; st.o[r] = 0.f; } }

DI void phase_attn(const P& p, LAS unsigned char* lds, int bid, int G) {
    int tid = mk_tid(p.hi); const int lane = tid & 63, wave = tid >> 6; unsigned char* ws = p.ws;
    const bf16_t *NQ = (const bf16_t*)(ws + WS_NQ), *KSLC = (const bf16_t*)(ws + WS_KSLC), *VSLC = (const bf16_t*)(ws + WS_VSLC), *KWIN = (const bf16_t*)(ws + WS_KWIN), *VWIN = (const bf16_t*)(ws + WS_VWIN);
    const bf16_t *KC = (const bf16_t*)(ws + WS_KC), *VC = (const bf16_t*)(ws + WS_VC); const float* GATES = (const float*)(ws + WS_GATES); bf16_t* MIX = (bf16_t*)(ws + WS_MIX);
    LAS float* qs = (LAS float*)lds + wave * 1024; LAS float* ps = qs + 256; LAS float* pcs = ps + 256;
    const int gw = bid * 8 + wave, NGW = G * 8;
#pragma unroll 1
    for (int task = NP * 4 + gw; task < MT * 4; task += NGW) {
        const int m = task >> 2, g = task & 3; const bool prompt = m < NP;
        const int b = prompt ? (m >> 11) : ((m - NP) >> 3), t = prompt ? (m & 2047) : ((m - NP) & 7), qpos = prompt ? t : 2048 + t, bb = prompt ? b : 4 + b;
        float slope[4];
#pragma unroll
        for (int r = 0; r < 4; ++r) { slope[r] = exp2f(-0.5f * (float)(g * 4 + r + 1)); qs[r * 64 + lane] = bf2f(NQ[(size_t)m * 1024 + (g * 4 + r) * 64 + lane]); }
        LDS_WAIT();
        float res[4] = {0.f, 0.f, 0.f, 0.f};
        const float* gt = GATES + (size_t)m * 48 + g * 12;
        AttnState st;
        const bf16_t* kc = KC + ((size_t)bb * 4 + g) * 128 * 64; const bf16_t* vc = VC + ((size_t)bb * 4 + g) * 128 * 64;
        float pc0[4], pc1[4];
        {
            float s0[4] = {0.f, 0.f, 0.f, 0.f}, s1[4] = {0.f, 0.f, 0.f, 0.f};
            const int d0 = qpos - 31 - 16 * lane, d1 = d0 - 1024; const bool v0 = d0 >= 0, v1 = d1 >= 0 && lane < 63;
            if (v0) dot4_row<bf16_t>(qs, kc + lane * 64, s0);
            if (v1) dot4_row<bf16_t>(qs, kc + (64 + lane) * 64, s1);
            float psum0 = 0.f, psum1 = 0.f;
#pragma unroll
            for (int r = 0; r < 4; ++r) { const float a0 = v0 ? s0[r] - slope[r] * (float)d0 : -INFINITY, a1 = v1 ? s1[r] - slope[r] * (float)d1 : -INFINITY;
                float mx = wave_max(fmaxf(a0, a1)); if (mx == -INFINITY) mx = 0.f;
                const float e0 = v0 ? __expf(a0 - mx) : 0.f, e1 = v1 ? __expf(a1 - mx) : 0.f; const float inv = 1.f / fmaxf(wave_sum(e0 + e1), 1e-30f);
                pc0[r] = e0 * inv; pc1[r] = e1 * inv; psum0 += pc0[r]; psum1 += pc1[r]; }
            pcs[lane] = psum0; pcs[64 + lane] = psum1; if (lane < 4) pcs[128 + lane] = 0.f;
            float oc[4] = {0.f, 0.f, 0.f, 0.f};
            *(LAS f32x4*)(ps + lane * 4) = (f32x4){pc0[0], pc0[1], pc0[2], pc0[3]}; LDS_WAIT();
#pragma unroll 4
            for (int kk = 0; kk < 64; ++kk) { const float v = bf2f(vc[kk * 64 + lane]); const f32x4 pv = *(const LAS f32x4*)(ps + kk * 4); oc[0] += pv.x * v; oc[1] += pv.y * v; oc[2] += pv.z * v; oc[3] += pv.w * v; }
            LDS_WAIT();
            *(LAS f32x4*)(ps + lane * 4) = (f32x4){pc1[0], pc1[1], pc1[2], pc1[3]}; LDS_WAIT();
#pragma unroll 3
            for (int kk = 0; kk < 63; ++kk) { const float v = bf2f(vc[(64 + kk) * 64 + lane]); const f32x4 pv = *(const LAS f32x4*)(ps + kk * 4); oc[0] += pv.x * v; oc[1] += pv.y * v; oc[2] += pv.z * v; oc[3] += pv.w * v; }
            LDS_WAIT();
#pragma unroll
            for (int r = 0; r < 4; ++r) res[r] += gt[r * 3 + 0] * oc[r];
        }
        unsigned long long selmask;
        {
            const int cur = qpos >> 6, j = lane; float imp = 0.f;
            if (j < 33) { imp = pcs[4 * j] + pcs[4 * j + 1] + pcs[4 * j + 2] + 0.5f * pcs[4 * j + 3]; if (j > 0) imp += 0.5f * pcs[4 * j - 1]; }
            const bool vj = j <= cur && j < 33, forced = (j == 0) || (j == cur) || (j == cur - 1);
            const float score = !vj ? -INFINITY : (forced ? INFINITY : imp);
            int rank = 0;
            for (int q = 0; q < 33; ++q) { const float sq = __shfl(score, q); rank += (sq > score || (sq == score && q < j)) ? 1 : 0; }
            selmask = __ballot(vj && rank < 16);
        }
        attn_reset(st);
#pragma unroll 1
        for (int j = 0; j < 33; ++j) {
            if (!((selmask >> j) & 1ull)) continue;
            if (prompt) { const size_t r0 = ((size_t)b * 2048 + 64 * j) * 256 + g * 64; attend_chunk<bf16_t>(st, qs, ps, KSLC + r0, VSLC + r0, 256, 64, qpos - 64 * j, 1, 1 << 30, slope, lane); }
            else if (j < 32) { const int page = p.page_table[b * 16 + (j >> 1)]; const float* r0 = p.cache_kv + ((size_t)page * 128 + (j & 1) * 64) * 1024 + g * 64;
                attend_chunk<float>(st, qs, ps, r0 + 512, r0 + 768, 1024, 64, qpos - 64 * j, 1, 1 << 30, slope, lane); }
            else { const size_t r0 = ((size_t)NP + b * 8) * 256 + g * 64; attend_chunk<bf16_t>(st, qs, ps, KSLC + r0, VSLC + r0, 256, 8, qpos - 2048, 1, 1 << 30, slope, lane); }
        }
#pragma unroll
        for (int r = 0; r < 4; ++r) res[r] += gt[r * 3 + 1] * st.o[r] / fmaxf(st.l[r], 1e-30f);
        attn_reset(st);
        if (prompt) { const int k0 = t - 511 > 0 ? t - 511 : 0;
#pragma unroll 1
            for (int c0 = k0; c0 <= t; c0 += 64) { const size_t r0 = ((size_t)b * 2048 + c0) * 256 + g * 64; const int nk = (t - c0 + 1) < 64 ? (t - c0 + 1) : 64;
                attend_chunk<bf16_t>(st, qs, ps, KWIN + r0, VWIN + r0, 256, nk, t - c0, 1, 512, slope, lane); } }
        else {
#pragma unroll 1
            for (int s0 = 0; s0 < 512; s0 += 64) { const float* r0 = p.cache_win + ((size_t)b * 512 + s0) * 512 + g * 64;
                attend_chunk<float>(st, qs, ps, r0, r0 + 256, 512, 64, qpos - (1536 + s0), 1, 512, slope, lane); }
            const size_t r0 = ((size_t)NP + b * 8) * 256 + g * 64; attend_chunk<bf16_t>(st, qs, ps, KWIN + r0, VWIN + r0, 256, 8, qpos - 2048, 1, 512, slope, lane); }
#pragma unroll
        for (int r = 0; r < 4; ++r) { res[r] += gt[r * 3 + 2] * st.o[r] / fmaxf(st.l[r], 1e-30f); MIX[(size_t)m * 2048 + 1024 + (g * 4 + r) * 64 + lane] = (bf16_t)f2bf(res[r]); }
        LDS_WAIT();
    }
}

DI void phase_conv(const P& p, int bid, int G) {
    int tid = mk_tid(p.hi); unsigned char* ws = p.ws;
    const bf16_t* U = (const bf16_t*)(ws + WS_U); bf16_t* ACT = (bf16_t*)(ws + WS_ACT);
    for (size_t i = (size_t)bid * 512 + tid; i < (size_t)MT * (FF / 4); i += (size_t)G * 512) {
        const int m = (int)(i / (FF / 4)), n = (int)(i % (FF / 4)) * 4;
        const bool prompt = m < NP; const int b = prompt ? (m >> 11) : ((m - NP) >> 3), t = prompt ? (m & 2047) : ((m - NP) & 7);
        float c2[2][4];
#pragma unroll
        for (int hf = 0; hf < 2; ++hf) { const int col = n + hf * FF;
            const f32x4 w0 = *(const f32x4*)(p.conv_w + col), w1 = *(const f32x4*)(p.conv_w + FF2 + col), w2 = *(const f32x4*)(p.conv_w + 2 * FF2 + col), cb = *(const f32x4*)(p.conv_b + col);
            f32x4 u0, u1, u2;
            { const u32x2 r = *(const u32x2*)(U + (size_t)m * FF2 + col); u2 = (f32x4){__uint_as_float(r.x << 16), __uint_as_float(r.x & 0xffff0000u), __uint_as_float(r.y << 16), __uint_as_float(r.y & 0xffff0000u)}; }
            if (t >= 1) { const u32x2 r = *(const u32x2*)(U + (size_t)(m - 1) * FF2 + col); u1 = (f32x4){__uint_as_float(r.x << 16), __uint_as_float(r.x & 0xffff0000u), __uint_as_float(r.y << 16), __uint_as_float(r.y & 0xffff0000u)}; }
            else if (prompt) u1 = (f32x4){0.f, 0.f, 0.f, 0.f}; else u1 = *(const f32x4*)(p.state_conv + ((size_t)b * 2 + 1) * FF2 + col);
            if (t >= 2) { const u32x2 r = *(const u32x2*)(U + (size_t)(m - 2) * FF2 + col); u0 = (f32x4){__uint_as_float(r.x << 16), __uint_as_float(r.x & 0xffff0000u), __uint_as_float(r.y << 16), __uint_as_float(r.y & 0xffff0000u)}; }
            else if (prompt) u0 = (f32x4){0.f, 0.f, 0.f, 0.f}; else u0 = *(const f32x4*)(p.state_conv + ((size_t)b * 2 + t) * FF2 + col);
            const f32x4 c = cb + w2 * u2 + w1 * u1 + w0 * u0; c2[hf][0] = c.x; c2[hf][1] = c.y; c2[hf][2] = c.z; c2[hf][3] = c.w; }
        u32x2 w; w.x = pk2(silu_f(c2[0][0]) * c2[1][0], silu_f(c2[0][1]) * c2[1][1]); w.y = pk2(silu_f(c2[0][2]) * c2[1][2], silu_f(c2[0][3]) * c2[1][3]);
        *(u32x2*)(ACT + (size_t)m * FF + n) = w;
    }
}


typedef short bf16x8 __attribute__((ext_vector_type(8)));
typedef short s16x4 __attribute__((ext_vector_type(4)));
typedef float f32x16 __attribute__((ext_vector_type(16)));
typedef __bf16 bf16x2v __attribute__((ext_vector_type(2)));
typedef float f32x2v __attribute__((ext_vector_type(2)));
#define MFMA32(a, b, c) __builtin_amdgcn_mfma_f32_32x32x16_bf16((a), (b), (c), 0, 0, 0)
constexpr int TS = 72;
constexpr float LOG2E = 1.4426950408889634f;
DI unsigned cvt2(float a, float b) { return __builtin_bit_cast(unsigned, __builtin_convertvector((f32x2v){a, b}, bf16x2v)); }
template <int S> DI bf16x8 pack_step(const f32x16& x) {
    u32x4 p; p.x = cvt2(x[8 * S + 0], x[8 * S + 1]); p.y = cvt2(x[8 * S + 2], x[8 * S + 3]); p.z = cvt2(x[8 * S + 4], x[8 * S + 5]); p.w = cvt2(x[8 * S + 6], x[8 * S + 7]);
    return __builtin_bit_cast(bf16x8, p); }
DI float xor32(float v) { return __shfl_xor(v, 32); }

struct TileRegs { u32x4 k, v; };
DI TileRegs tile_load(const bf16_t* ksrc, const bf16_t* vtsrc, int ldv, int tid) {
    TileRegs r; const int row = tid >> 3, ch = tid & 7;
    r.k = *(const u32x4*)(ksrc + (size_t)row * 64 + ch * 8); r.v = *(const u32x4*)(vtsrc + (size_t)row * ldv + ch * 8); return r; }
DI void tile_store(LAS bf16_t* kt, LAS bf16_t* vt, const TileRegs& r, int tid) {
    const int row = tid >> 3, ch = tid & 7; *(LAS u32x4*)(kt + row * TS + ch * 8) = r.k; *(LAS u32x4*)(vt + row * TS + ch * 8) = r.v; }

DI void qk_tile(const LAS bf16_t* kt, const bf16x8 (&qf)[4], int r32, int h, f32x16 (&S)[2]) {
#pragma unroll
    for (int sub = 0; sub < 2; ++sub) {
        f32x16 acc;
#pragma unroll
        for (int i = 0; i < 16; ++i) acc[i] = 0.f;
#pragma unroll
        for (int kk = 0; kk < 4; ++kk) { const bf16x8 a = *(const LAS bf16x8*)(kt + (sub * 32 + r32) * TS + kk * 16 + h * 8); acc = MFMA32(a, qf[kk], acc); }
        S[sub] = acc; }
}
DI void pv_tile(const LAS bf16_t* vt, const f32x16 (&P)[2], int r32, int h, f32x16 (&O)[2]) {
#pragma unroll
    for (int sub = 0; sub < 2; ++sub) {
        const bf16x8 p0 = pack_step<0>(P[sub]), p1 = pack_step<1>(P[sub]);
#pragma unroll
        for (int db = 0; db < 2; ++db) {
            const LAS bf16_t* vr = vt + (db * 32 + r32) * TS + sub * 32 + 4 * h;
            const s16x4 a0 = *(const LAS s16x4*)(vr), a1 = *(const LAS s16x4*)(vr + 8), b0 = *(const LAS s16x4*)(vr + 16), b1 = *(const LAS s16x4*)(vr + 24);
            O[db] = MFMA32(__builtin_shufflevector(a0, a1, 0, 1, 2, 3, 4, 5, 6, 7), p0, O[db]);
            O[db] = MFMA32(__builtin_shufflevector(b0, b1, 0, 1, 2, 3, 4, 5, 6, 7), p1, O[db]); } }
}

template <int MODE> DI void attn_tile(const LAS bf16_t* kt, const LAS bf16_t* vt, const bf16x8 (&qf)[4], int r32, int h, int d0, bool rowsel, float slope2, float& mrun, float& lrun, f32x16 (&O)[2]) {
    f32x16 S[2]; qk_tile(kt, qf, r32, h, S);
    const float c1 = -slope2 * (float)d0; float tmax = -INFINITY;
#pragma unroll
    for (int sub = 0; sub < 2; ++sub)
#pragma unroll
        for (int i = 0; i < 16; ++i) { const int off = sub * 32 + (i & 3) + 8 * (i >> 2);
            bool valid = rowsel && (off <= d0); if (MODE == 2) valid = valid && (d0 - off < 512);
            const float s2 = fmaf(S[sub][i], LOG2E, fmaf(slope2, (float)off, c1)); S[sub][i] = valid ? s2 : -INFINITY; tmax = fmaxf(tmax, S[sub][i]); }
    tmax = fmaxf(tmax, xor32(tmax));
    const float mnew = fmaxf(mrun, tmax), alpha = __builtin_amdgcn_exp2f(mrun - mnew); mrun = mnew;
    float psum = 0.f;
#pragma unroll
    for (int sub = 0; sub < 2; ++sub)
#pragma unroll
        for (int i = 0; i < 16; ++i) { const float pr = __builtin_amdgcn_exp2f(S[sub][i] - mnew); psum += pr; S[sub][i] = pr; }
    lrun = lrun * alpha + psum;
#pragma unroll
    for (int db = 0; db < 2; ++db)
#pragma unroll
        for (int i = 0; i < 16; ++i) O[db][i] *= alpha;
    pv_tile(vt, S, r32, h, O);
}

DI void phase_attn_prompt(const P& p, LAS unsigned char* lds, int bid, int G, int rnd0, int rnd1) {
    int tid = mk_tid(p.hi); const int lane = tid & 63, wave = tid >> 6, r32 = lane & 31, h = lane >> 5, ti = r32 & 7, rr = r32 >> 3;
    unsigned char* ws = p.ws;
    const bf16_t *NQ = (const bf16_t*)(ws + WS_NQ), *KSP = (const bf16_t*)(ws + WS_KSP), *VSPT = (const bf16_t*)(ws + WS_VSPT), *KWP = (const bf16_t*)(ws + WS_KWP), *VWPT = (const bf16_t*)(ws + WS_VWPT);
    const bf16_t *KC = (const bf16_t*)(ws + WS_KC), *VCT = (const bf16_t*)(ws + WS_VCT); const float* GATES = (const float*)(ws + WS_GATES); bf16_t* MIX = (bf16_t*)(ws + WS_MIX);
    LAS bf16_t* KT = (LAS bf16_t*)lds; LAS bf16_t* VT = KT + 2 * 64 * TS; LAS unsigned* UM = (LAS unsigned*)(VT + 2 * 64 * TS);
    LAS float* RES = (LAS float*)(lds + 40960) + wave * 2048 + lane;
#pragma unroll 1
    for (int rnd = rnd0; rnd < rnd1; ++rnd) {
        const int it = bid + rnd * G; if (it >= 512) break;
        const int v = (rnd & 1) ? (rnd * G + (G - 1 - it % G)) : it; if (v >= 512) continue;
        const int qt = v >> 4, b = (v >> 2) & 3, g = v & 3, t0 = qt * 64, tq = t0 + 8 * wave + ti, hd = g * 4 + rr;
        const size_t m = (size_t)b * 2048 + tq; const int bg = b * 4 + g;
        bf16x8 qf[4];
#pragma unroll
        for (int kk = 0; kk < 4; ++kk) qf[kk] = *(const bf16x8*)(NQ + m * 1024 + hd * 64 + kk * 16 + h * 8);
        const float slope2 = exp2f(-0.5f * (float)(hd + 1)) * LOG2E;
        const float gt0 = GATES[m * 48 + hd * 3 + 0], gt1 = GATES[m * 48 + hd * 3 + 1], gt2 = GATES[m * 48 + hd * 3 + 2];
        if (tid == 0) UM[0] = 0u;
        unsigned rowmask;
        {
            __syncthreads();
            { const bf16_t* kc = KC + (size_t)bg * 128 * 64; const bf16_t* vc = VCT + (size_t)bg * 64 * 128;
              const TileRegs a = tile_load(kc, vc, 128, tid), c = tile_load(kc + 64 * 64, vc + 64, 128, tid);
              tile_store(KT, VT, a, tid); tile_store(KT + 64 * TS, VT + 64 * TS, c, tid); }
            __syncthreads();
            f32x16 S[4];
            { f32x16 T2[2]; qk_tile(KT, qf, r32, h, T2); S[0] = T2[0]; S[1] = T2[1]; qk_tile(KT + 64 * TS, qf, r32, h, T2); S[2] = T2[0]; S[3] = T2[1]; }
            const int dq = tq - 31 - 64 * h; const float c1 = -slope2 * (float)dq; float tmax = -INFINITY;
#pragma unroll
            for (int s4 = 0; s4 < 4; ++s4)
#pragma unroll
                for (int i = 0; i < 16; ++i) { const int off16 = 16 * (s4 * 32 + (i & 3) + 8 * (i >> 2));
                    const float s2 = fmaf(S[s4][i], LOG2E, fmaf(slope2, (float)off16, c1)); S[s4][i] = (off16 <= dq) ? s2 : -INFINITY; tmax = fmaxf(tmax, S[s4][i]); }
            tmax = fmaxf(tmax, xor32(tmax));
            const float mx = fmaxf(tmax, -1e30f); float psum = 0.f;
#pragma unroll
            for (int s4 = 0; s4 < 4; ++s4)
#pragma unroll
                for (int i = 0; i < 16; ++i) { const float pr = __builtin_amdgcn_exp2f(S[s4][i] - mx); psum += pr; S[s4][i] = pr; }
            psum += xor32(psum);
            const float inv = 1.f / fmaxf(psum, 1e-30f);
#pragma unroll
            for (int s4 = 0; s4 < 4; ++s4)
#pragma unroll
                for (int i = 0; i < 16; ++i) S[s4][i] *= inv;
            f32x16 O[2];
#pragma unroll
            for (int db = 0; db < 2; ++db)
#pragma unroll
                for (int i = 0; i < 16; ++i) O[db][i] = 0.f;
            { f32x16 T2[2]; T2[0] = S[0]; T2[1] = S[1]; pv_tile(VT, T2, r32, h, O); T2[0] = S[2]; T2[1] = S[3]; pv_tile(VT + 64 * TS, T2, r32, h, O); }
#pragma unroll
            for (int db = 0; db < 2; ++db)
#pragma unroll
                for (int i = 0; i < 16; ++i) RES[64 * (db * 16 + i)] = gt0 * O[db][i];
            float imp[16], tl[16];
#pragma unroll
            for (int k = 0; k < 16; ++k) { const f32x16& T = S[k >> 2]; const int q = (k & 3) * 4; tl[k] = T[q + 3]; imp[k] = (T[q] + T[q + 1]) + (T[q + 2] + 0.5f * T[q + 3]); }
#pragma unroll
            for (int k = 0; k < 16; ++k) tl[k] = xor32(tl[k]);
#pragma unroll
            for (int k = 0; k < 16; ++k) { const float prev = h ? tl[k] : (k > 0 ? tl[k > 0 ? k - 1 : 0] : 0.f); float x = imp[k] + 0.5f * prev; x += __shfl_xor(x, 8); x += __shfl_xor(x, 16); imp[k] = x; }
            const int cur = tq >> 6;
            float sc[16], sp[16];
#pragma unroll
            for (int k = 0; k < 16; ++k) { const int j = 2 * k + h; const bool vj = j <= cur, forced = (j == 0) || (j == cur) || (j == cur - 1); sc[k] = !vj ? -INFINITY : (forced ? INFINITY : imp[k]); }
#pragma unroll
            for (int k = 0; k < 16; ++k) sp[k] = xor32(sc[k]);
            unsigned own = 0u;
#pragma unroll
            for (int k = 0; k < 16; ++k) { int rank = 0; const float me = sc[k];
#pragma unroll
                for (int q = 0; q < 16; ++q) { if (q < k) rank += (sc[q] >= me) ? 1 : 0; else if (q > k) rank += (sc[q] > me) ? 1 : 0;
                    if (q < k) rank += (sp[q] >= me) ? 1 : 0; else if (q > k) rank += (sp[q] > me) ? 1 : 0; else rank += (h ? (sp[q] >= me) : (sp[q] > me)) ? 1 : 0; }
                if (me > -INFINITY && rank < 16) own |= 1u << (2 * k + h); }
            rowmask = own | (unsigned)__shfl_xor((int)own, 32);
        }
        unsigned wm = rowmask; wm |= (unsigned)__shfl_xor((int)wm, 1); wm |= (unsigned)__shfl_xor((int)wm, 2); wm |= (unsigned)__shfl_xor((int)wm, 4);
        const unsigned wavemask = (unsigned)__builtin_amdgcn_readfirstlane((int)wm);
        if (lane == 0) atomicOr((unsigned*)UM, wavemask);
        __syncthreads();
        const unsigned umask = UM[0];
        {
            const bf16_t* kb = KSP + (size_t)bg * 2048 * 64; const bf16_t* vb = VSPT + (size_t)bg * 64 * 2048;
            float mrun = -1e30f, lrun = 0.f; f32x16 O[2];
#pragma unroll
            for (int db = 0; db < 2; ++db)
#pragma unroll
                for (int i = 0; i < 16; ++i) O[db][i] = 0.f;
            unsigned rem = umask; int buf = 0;
            int jc = rem ? __builtin_ctz(rem) : -1; if (jc >= 0) rem &= rem - 1;
            if (jc >= 0) { const TileRegs a = tile_load(kb + (size_t)jc * 64 * 64, vb + jc * 64, 2048, tid); tile_store(KT, VT, a, tid); }
            __syncthreads();
#pragma unroll 1
            while (jc >= 0) {
                const int jn = rem ? __builtin_ctz(rem) : -1; if (jn >= 0) rem &= rem - 1;
                TileRegs nx; if (jn >= 0) nx = tile_load(kb + (size_t)jn * 64 * 64, vb + jn * 64, 2048, tid);
                if ((wavemask >> jc) & 1u) attn_tile<1>(KT + buf * 64 * TS, VT + buf * 64 * TS, qf, r32, h, tq - 4 * h - 64 * jc, ((rowmask >> jc) & 1u) != 0u, slope2, mrun, lrun, O);
                if (jn >= 0) tile_store(KT + (buf ^ 1) * 64 * TS, VT + (buf ^ 1) * 64 * TS, nx, tid);
                __syncthreads();
                buf ^= 1; jc = jn;
            }
            const float inv = gt1 / fmaxf(lrun + xor32(lrun), 1e-30f);
#pragma unroll
            for (int db = 0; db < 2; ++db)
#pragma unroll
                for (int i = 0; i < 16; ++i) RES[64 * (db * 16 + i)] += inv * O[db][i];
        }
        {
            const bf16_t* kb = KWP + (size_t)bg * 2048 * 64; const bf16_t* vb = VWPT + (size_t)bg * 64 * 2048;
            float mrun = -1e30f, lrun = 0.f; f32x16 O[2];
#pragma unroll
            for (int db = 0; db < 2; ++db)
#pragma unroll
                for (int i = 0; i < 16; ++i) O[db][i] = 0.f;
            int jc = qt - 8 > 0 ? qt - 8 : 0, buf = 0;
            { const TileRegs a = tile_load(kb + (size_t)jc * 64 * 64, vb + jc * 64, 2048, tid); tile_store(KT, VT, a, tid); }
            __syncthreads();
#pragma unroll 1
            while (jc >= 0) {
                const int jn = jc < qt ? jc + 1 : -1;
                TileRegs nx; if (jn >= 0) nx = tile_load(kb + (size_t)jn * 64 * 64, vb + jn * 64, 2048, tid);
                attn_tile<2>(KT + buf * 64 * TS, VT + buf * 64 * TS, qf, r32, h, tq - 4 * h - 64 * jc, true, slope2, mrun, lrun, O);
                if (jn >= 0) tile_store(KT + (buf ^ 1) * 64 * TS, VT + (buf ^ 1) * 64 * TS, nx, tid);
                __syncthreads();
                buf ^= 1; jc = jn;
            }
            const float inv = gt2 / fmaxf(lrun + xor32(lrun), 1e-30f);
            bf16_t* orow = MIX + m * 2048 + 1024 + hd * 64 + 4 * h;
#pragma unroll
            for (int db = 0; db < 2; ++db)
#pragma unroll
                for (int q = 0; q < 4; ++q) { float y[4];
#pragma unroll
                    for (int e = 0; e < 4; ++e) y[e] = RES[64 * (db * 16 + 4 * q + e)] + inv * O[db][4 * q + e];
                    u32x2 w; w.x = cvt2(y[0], y[1]); w.y = cvt2(y[2], y[3]); *(u32x2*)(orow + db * 32 + 8 * q) = w; }
        }
    }
}

constexpr int CL2_WP = 264;
constexpr int CL2_LDS = 2 * 64 * CL2_WP * 2 + 2 * 256 * 4;
DI void cmp_l2_setup(const P& p, LAS unsigned char* tab, int tid) {
    LAS bf16_t* W2T = (LAS bf16_t*)tab; LAS float* BIAS = (LAS float*)(W2T + 2 * 64 * CL2_WP); const float* PEB = (const float*)(p.ws + CTL_PEB);
    __syncthreads();
    for (int i = tid; i < 2 * 256 * 64; i += 512) { const int c = i >> 14, hh = (i >> 6) & 255, d = i & 63; W2T[(c * 64 + d) * CL2_WP + hh] = (bf16_t)f2bf(p.cmp_w2[i]); }
    BIAS[tid] = PEB[tid] + p.cmp_b1[tid];
    __syncthreads();
}
template <int KB  > DI void cmp_l2_task(const P& p, const LAS unsigned char* tab, int c, int bg, int quarter, int lane) {
    const int r32 = lane & 31, h = lane >> 5; unsigned char* ws = p.ws; constexpr int WP = CL2_WP;
    const bf16_t* HPRE = (const bf16_t*)(ws + WS_HPRE); bf16_t *KC = (bf16_t*)(ws + WS_KC), *VC = (bf16_t*)(ws + WS_VC), *VCT = (bf16_t*)(ws + WS_VCT);
    const LAS bf16_t* W2T = (const LAS bf16_t*)tab; const LAS float* BIAS = (const LAS float*)(W2T + 2 * 64 * WP);
    {
        const int i0 = quarter * 32, i = i0 + r32;
        const size_t row = (size_t)bg * 128 + i;
        const bf16_t* h0 = HPRE + ((size_t)c * CM + row) * 512 + 8 * h; const bf16_t* h1 = h0 + 512 + 256;
        f32x16 O[2];
#pragma unroll
        for (int db = 0; db < 2; ++db)
#pragma unroll
            for (int q = 0; q < 16; ++q) O[db][q] = 0.f;
#pragma unroll 1
        for (int k0 = 0; k0 < 16; k0 += KB) {
        u32x4 ra[KB], rb[KB];
#pragma unroll
        for (int kq = 0; kq < KB; ++kq) { ra[kq] = *(const u32x4*)(h0 + (k0 + kq) * 16); rb[kq] = *(const u32x4*)(h1 + (k0 + kq) * 16); }
#pragma unroll
        for (int kq = 0; kq < KB; ++kq) { const int kk = k0 + kq;
            const unsigned aw[4] = {ra[kq].x, ra[kq].y, ra[kq].z, ra[kq].w}, bw[4] = {rb[kq].x, rb[kq].y, rb[kq].z, rb[kq].w};
            const LAS float* bs = BIAS + c * 256 + kk * 16 + 8 * h; const f32x4 b0 = *(const LAS f32x4*)bs, b1 = *(const LAS f32x4*)(bs + 4);
            float x[8];
#pragma unroll
            for (int j = 0; j < 8; ++j) { const unsigned wa = aw[j >> 1], wb = bw[j >> 1]; const float av = (j & 1) ? __uint_as_float(wa & 0xffff0000u) : __uint_as_float(wa << 16), bv = (j & 1) ? __uint_as_float(wb & 0xffff0000u) : __uint_as_float(wb << 16);
                x[j] = silu_f(av + bv + (j < 4 ? b0[j & 3] : b1[j & 3])); }
            u32x4 pk; pk.x = cvt2(x[0], x[1]); pk.y = cvt2(x[2], x[3]); pk.z = cvt2(x[4], x[5]); pk.w = cvt2(x[6], x[7]);
            const bf16x8 bf = __builtin_bit_cast(bf16x8, pk);
#pragma unroll
            for (int db = 0; db < 2; ++db) { const bf16x8 af = *(const LAS bf16x8*)(W2T + (c * 64 + db * 32 + r32) * WP + kk * 16 + 8 * h); O[db] = MFMA32(af, bf, O[db]); }
        }
        }
        float ss = 0.f;
#pragma unroll
        for (int db = 0; db < 2; ++db)
#pragma unroll
            for (int q = 0; q < 16; ++q) { const int d = 32 * db + (q & 3) + 8 * (q >> 2) + 4 * h; O[db][q] += p.cmp_b2[c * 64 + d]; ss += O[db][q] * O[db][q]; }
        ss += xor32(ss);
        const float r = (c == 0) ? rsqrtf(ss * (1.f / 64.f) + EPS) : 1.f; const bool live = i < 127;
#pragma unroll
        for (int db = 0; db < 2; ++db)
#pragma unroll
            for (int q4 = 0; q4 < 4; ++q4) { float y[4];
#pragma unroll
                for (int e = 0; e < 4; ++e) { const int d = 32 * db + e + 8 * q4 + 4 * h; float v = O[db][4 * q4 + e] * r; if (c == 0) v *= p.k_norm_cmp[d]; y[e] = live ? v : 0.f; }
                u32x2 w; w.x = cvt2(y[0], y[1]); w.y = cvt2(y[2], y[3]);
                *(u32x2*)((c ? VC : KC) + row * 64 + 32 * db + 8 * q4 + 4 * h) = w;
                if (c) {
#pragma unroll
                    for (int e = 0; e < 4; ++e) VCT[((size_t)bg * 64 + 32 * db + e + 8 * q4 + 4 * h) * 128 + i] = (bf16_t)(e & 1 ? (e == 1 ? w.x >> 16 : w.y >> 16) : (e == 0 ? w.x & 0xffffu : w.y & 0xffffu)); } }
    }
}
DI void phase_cmp_l2_mfma(const P& p, LAS unsigned char* lds, int bid, int G) {
    int tid = mk_tid(p.hi); const int lane = tid & 63, wave = tid >> 6;
    cmp_l2_setup(p, lds, tid);
#pragma unroll 1
    for (int task = bid * 8 + wave; task < 128; task += G * 8) cmp_l2_task<16>(p, lds, task >> 6, (task >> 2) & 15, task & 3, lane);
}

constexpr int VP = 40;
DI bf16x8 pack8f(const f32x4& a, const f32x4& b) { u32x4 p; p.x = cvt2(a.x, a.y); p.y = cvt2(a.z, a.w); p.z = cvt2(b.x, b.y); p.w = cvt2(b.z, b.w); return __builtin_bit_cast(bf16x8, p); }
DI void load_k32_f32(const float* kbase, int stride, int r32, int h, bf16x8 (&kf)[4]) {
    const float* kr = kbase + (size_t)r32 * stride + 8 * h;
#pragma unroll
    for (int kk = 0; kk < 4; ++kk) kf[kk] = pack8f(*(const f32x4*)(kr + 16 * kk), *(const f32x4*)(kr + 16 * kk + 4)); }
DI void stage_v32_f32(const float* vbase, int stride, LAS bf16_t* vt, int lane) {
    const int d4 = lane & 15, kg = lane >> 4;
#pragma unroll
    for (int it = 0; it < 2; ++it) { f32x4 v[4];
#pragma unroll
        for (int e = 0; e < 4; ++e) v[e] = *(const f32x4*)(vbase + (size_t)(16 * it + 4 * kg + e) * stride + 4 * d4);
#pragma unroll
        for (int dd = 0; dd < 4; ++dd) { u32x2 w; w.x = cvt2(v[0][dd], v[1][dd]); w.y = cvt2(v[2][dd], v[3][dd]); *(LAS u32x2*)(vt + (4 * d4 + dd) * VP + 16 * it + 4 * kg) = w; } }
}
DI void load_v32_lds(const LAS bf16_t* vt, int r32, int h, bf16x8 (&va)[2][2]) {
#pragma unroll
    for (int db = 0; db < 2; ++db)
#pragma unroll
        for (int s = 0; s < 2; ++s) { const LAS bf16_t* vr = vt + (db * 32 + r32) * VP + 16 * s + 4 * h; const s16x4 a0 = *(const LAS s16x4*)vr, a1 = *(const LAS s16x4*)(vr + 8); va[db][s] = __builtin_shufflevector(a0, a1, 0, 1, 2, 3, 4, 5, 6, 7); }
}

struct RawT { f32x4 k[8], v[8]; };
DI void raw_load(RawT& r, const float* kbase, const float* vbase, int stride, int r32, int h, int lane) {
    const float* kr = kbase + (size_t)r32 * stride + 8 * h; const int d4 = lane & 15, kg = lane >> 4;
#pragma unroll
    for (int kk = 0; kk < 4; ++kk) { r.k[2 * kk] = *(const f32x4*)(kr + 16 * kk); r.k[2 * kk + 1] = *(const f32x4*)(kr + 16 * kk + 4); }
#pragma unroll
    for (int it = 0; it < 2; ++it)
#pragma unroll
        for (int e = 0; e < 4; ++e) r.v[4 * it + e] = *(const f32x4*)(vbase + (size_t)(16 * it + 4 * kg + e) * stride + 4 * d4);
}
DI void raw_use(const RawT& r, LAS bf16_t* vt, int r32, int h, int lane, bf16x8 (&kf)[4], bf16x8 (&va)[2][2]) {
    const int d4 = lane & 15, kg = lane >> 4;
#pragma unroll
    for (int kk = 0; kk < 4; ++kk) kf[kk] = pack8f(r.k[2 * kk], r.k[2 * kk + 1]);
#pragma unroll
    for (int it = 0; it < 2; ++it)
#pragma unroll
        for (int dd = 0; dd < 4; ++dd) { u32x2 w; w.x = cvt2(r.v[4 * it][dd], r.v[4 * it + 1][dd]); w.y = cvt2(r.v[4 * it + 2][dd], r.v[4 * it + 3][dd]); *(LAS u32x2*)(vt + (4 * d4 + dd) * VP + 16 * it + 4 * kg) = w; }
    LDS_WAIT(); load_v32_lds(vt, r32, h, va);
}
template <int MODE> DI void attn_sub32(const bf16x8 (&kf)[4], const bf16x8 (&va)[2][2], const bf16x8 (&qf)[4], int d0, bool rowsel, float slope2, float& mrun, float& lrun, f32x16 (&O)[2]) {
    f32x16 S;
#pragma unroll
    for (int i = 0; i < 16; ++i) S[i] = 0.f;
#pragma unroll
    for (int kk = 0; kk < 4; ++kk) S = MFMA32(kf[kk], qf[kk], S);
    const float c1 = -slope2 * (float)d0; float tmax = -INFINITY;
#pragma unroll
    for (int i = 0; i < 16; ++i) { const int off = (i & 3) + 8 * (i >> 2); bool valid = rowsel && (off <= d0); if (MODE == 2) valid = valid && (d0 - off < 512);
        const float s2 = fmaf(S[i], LOG2E, fmaf(slope2, (float)off, c1)); S[i] = valid ? s2 : -INFINITY; tmax = fmaxf(tmax, S[i]); }
    tmax = fmaxf(tmax, xor32(tmax));
    const float mnew = fmaxf(mrun, tmax), alpha = __builtin_amdgcn_exp2f(mrun - mnew); mrun = mnew;
    float psum = 0.f;
#pragma unroll
    for (int i = 0; i < 16; ++i) { const float pr = __builtin_amdgcn_exp2f(S[i] - mnew); psum += pr; S[i] = pr; }
    lrun = lrun * alpha + psum;
#pragma unroll
    for (int db = 0; db < 2; ++db)
#pragma unroll
        for (int i = 0; i < 16; ++i) O[db][i] *= alpha;
    const bf16x8 p0 = pack_step<0>(S), p1 = pack_step<1>(S);
#pragma unroll
    for (int db = 0; db < 2; ++db) { O[db] = MFMA32(va[db][0], p0, O[db]); O[db] = MFMA32(va[db][1], p1, O[db]); }
}
DI void load_new_rows(const bf16_t* kbuf, const bf16_t* vbuf, size_t m0, int g, int r32, int h, bf16x8 (&kf)[4], bf16x8 (&va)[2][2]) {
#pragma unroll
    for (int kk = 0; kk < 4; ++kk) { u32x4 z = (u32x4){0u, 0u, 0u, 0u}; if (r32 < 8) z = *(const u32x4*)(kbuf + (m0 + r32) * 256 + g * 64 + 16 * kk + 8 * h); kf[kk] = __builtin_bit_cast(bf16x8, z); }
#pragma unroll
    for (int db = 0; db < 2; ++db) { bf16x8 a;
#pragma unroll
        for (int j = 0; j < 8; ++j) a[j] = 0;
#pragma unroll
        for (int j = 0; j < 4; ++j) a[j] = (short)vbuf[(m0 + 4 * h + j) * 256 + g * 64 + db * 32 + r32];
        va[db][0] = a;
#pragma unroll
        for (int j = 0; j < 8; ++j) a[j] = 0;
        va[db][1] = a; }
}

DI void phase_attn_sample(const P& p, LAS unsigned char* lds, int bid, int G) {
    const int wave = p.hi;
    unsigned char* ws = p.ws;
    const bf16_t *NQ = (const bf16_t*)(ws + WS_NQ), *KSLC = (const bf16_t*)(ws + WS_KSLC), *VSLC = (const bf16_t*)(ws + WS_VSLC), *KWIN = (const bf16_t*)(ws + WS_KWIN), *VWIN = (const bf16_t*)(ws + WS_VWIN);
    const bf16_t *KC = (const bf16_t*)(ws + WS_KC), *VCT = (const bf16_t*)(ws + WS_VCT); const float* GATES = (const float*)(ws + WS_GATES); bf16_t* MIX = (bf16_t*)(ws + WS_MIX);
    LAS bf16_t* vt = (LAS bf16_t*)lds + wave * 64 * VP;
    LAS float* XR = (LAS float*)(lds + 8 * 64 * VP * 2);
    LAS unsigned char* tab = lds + 61440;
    LAS float* PART0 = (LAS float*)(lds + 6 * 64 * VP * 2);
    LAS float* PART1 = (LAS float*)(lds + 61440 + CL2_LDS);
    LAS unsigned* MSK = (LAS unsigned*)(lds + 61440 + CL2_LDS + 34 * 64 * 4);
    static_assert(34 * 64 * 4 <= 2 * 64 * VP * 2 && 61440 + CL2_LDS + 34 * 64 * 4 + 2 * 34 * 4 <= LDS_MISC, "sample attention LDS map (3 waves per unit)");
    static_assert(8 * 64 * VP * 2 + 2 * 64 * 32 * 4 <= 61440 && 61440 + CL2_LDS <= LDS_MISC, "sample attention LDS map");
    static_assert(61440 + CL2_LDS + 34 * 64 * 4 + 2 * 34 * 4 <= 140288 && 140288 + 2 * 8448 <= LDS_MISC, "scratch of the two converting waves");
    { const int t0 = mk_tid(p.hi); if (t0 < 2) MSK[t0 * 34 + 33] = 0u; cmp_l2_setup(p, tab, t0); }
    const int ul = wave / 3, role = wave % 3;
    unsigned tag = 0u;
#pragma unroll 1
    for (int it = bid; it < 256; it += G) {
        const int lane = mk_tid(p.hi) & 63;
#pragma unroll 1
        for (int q = 0; q < 2; ++q) { const int t16 = wave + 8 * q, un = it * 2 + (t16 >> 3); cmp_l2_task<8>(p, tab, (t16 >> 2) & 1, (4 + (un >> 2)) * 4 + (un & 3), t16 & 3, lane); }
        asm volatile("s_waitcnt vmcnt(0)" ::: "memory"); __syncthreads();
        ++tag;
        if (wave >= 6) {
            LAS float* scr = (LAS float*)(lds + 140288 + (wave - 6) * 8448);
            ret_sample_wave(p, (LAS unsigned char*)scr, it * 2 + (wave - 6), lane);
            asm volatile("s_waitcnt vmcnt(0)" ::: "memory"); __syncthreads(); __syncthreads(); continue; }
        const int r32 = lane & 31, h = lane >> 5, ti = r32 & 7, rr = r32 >> 3;
        const int unit = it * 2 + ul, b = unit >> 2, g = unit & 3, hd = g * 4 + rr, qpos = 2048 + ti; const bool active = true;
        LAS float* part = (ul ? PART1 : PART0) + lane;
        const size_t m0 = (size_t)NP + b * 8, m = m0 + ti;
        f32x16 O[2]; float mrun = -1e30f, lrun = 0.f, gsel = 0.f;
        if (active) {
            bf16x8 qf[4];
#pragma unroll
            for (int kk = 0; kk < 4; ++kk) qf[kk] = *(const bf16x8*)(NQ + m * 1024 + hd * 64 + kk * 16 + h * 8);
            const float slope2 = exp2f(-0.5f * (float)(hd + 1)) * LOG2E;
#pragma unroll
            for (int db = 0; db < 2; ++db)
#pragma unroll
                for (int i = 0; i < 16; ++i) O[db][i] = 0.f;
            bf16x8 kf[4], va[2][2];
            if (role == 2) {
                const float gt2 = GATES[m * 48 + hd * 3 + 2];
                { const float* wb = p.cache_win + (size_t)b * 512 * 512 + g * 64; RawT ra;
                  raw_load(ra, wb, wb + 256, 512, r32, h, lane);
#pragma unroll 1
                  for (int s0 = 0; s0 < 512; s0 += 32) {
                      raw_use(ra, vt, r32, h, lane, kf, va);
                      if (s0 + 32 < 512) raw_load(ra, wb + (size_t)(s0 + 32) * 512, wb + (size_t)(s0 + 32) * 512 + 256, 512, r32, h, lane);
                      attn_sub32<2>(kf, va, qf, qpos - 4 * h - (1536 + s0), true, slope2, mrun, lrun, O); } }
                load_new_rows(KWIN, VWIN, m0, g, r32, h, kf, va);
                attn_sub32<2>(kf, va, qf, ti - 4 * h, true, slope2, mrun, lrun, O);
                const float inv = gt2 / fmaxf(lrun + xor32(lrun), 1e-30f);
#pragma unroll
                for (int db = 0; db < 2; ++db)
#pragma unroll
                    for (int q = 0; q < 4; ++q) *(LAS f32x4*)(XR + (ul * 64 + lane) * 32 + db * 16 + q * 4) = (f32x4){O[db][4 * q] * inv, O[db][4 * q + 1] * inv, O[db][4 * q + 2] * inv, O[db][4 * q + 3] * inv};
            } else {
                unsigned rowmask, rem; float gt1 = 0.f;
                volatile LAS unsigned* mk = MSK + ul * 34;
                if (role == 0) {
                const float gt0 = GATES[m * 48 + hd * 3 + 0]; gt1 = GATES[m * 48 + hd * 3 + 1]; const int bbg = (4 + b) * 4 + g;
                {
                    f32x16 S[4];
#pragma unroll
                    for (int s4 = 0; s4 < 4; ++s4) { f32x16 acc;
#pragma unroll
                        for (int i = 0; i < 16; ++i) acc[i] = 0.f;
#pragma unroll
                        for (int kk = 0; kk < 4; ++kk) { const bf16x8 a = *(const bf16x8*)(KC + ((size_t)bbg * 128 + s4 * 32 + r32) * 64 + kk * 16 + h * 8); acc = MFMA32(a, qf[kk], acc); }
                        S[s4] = acc; }
                    const int dq = qpos - 31 - 64 * h; const float c1 = -slope2 * (float)dq; float tmax = -INFINITY;
#pragma unroll
                    for (int s4 = 0; s4 < 4; ++s4)
#pragma unroll
                        for (int i = 0; i < 16; ++i) { const int off16 = 16 * (s4 * 32 + (i & 3) + 8 * (i >> 2));
                            const float s2 = fmaf(S[s4][i], LOG2E, fmaf(slope2, (float)off16, c1)); S[s4][i] = (off16 <= dq) ? s2 : -INFINITY; tmax = fmaxf(tmax, S[s4][i]); }
                    tmax = fmaxf(tmax, xor32(tmax));
                    const float mx = fmaxf(tmax, -1e30f); float psum = 0.f;
#pragma unroll
                    for (int s4 = 0; s4 < 4; ++s4)
#pragma unroll
                        for (int i = 0; i < 16; ++i) { const float pr = __builtin_amdgcn_exp2f(S[s4][i] - mx); psum += pr; S[s4][i] = pr; }
                    psum += xor32(psum);
                    const float invp = 1.f / fmaxf(psum, 1e-30f);
#pragma unroll
                    for (int s4 = 0; s4 < 4; ++s4)
#pragma unroll
                        for (int i = 0; i < 16; ++i) S[s4][i] *= invp;
#pragma unroll
                    for (int s4 = 0; s4 < 4; ++s4) { const bf16x8 p0 = pack_step<0>(S[s4]), p1 = pack_step<1>(S[s4]);
#pragma unroll
                        for (int db = 0; db < 2; ++db) { const bf16_t* vr = VCT + ((size_t)bbg * 64 + db * 32 + r32) * 128 + s4 * 32 + 4 * h;
                            const s16x4 a0 = *(const s16x4*)vr, a1 = *(const s16x4*)(vr + 8), b0 = *(const s16x4*)(vr + 16), b1 = *(const s16x4*)(vr + 24);
                            O[db] = MFMA32(__builtin_shufflevector(a0, a1, 0, 1, 2, 3, 4, 5, 6, 7), p0, O[db]); O[db] = MFMA32(__builtin_shufflevector(b0, b1, 0, 1, 2, 3, 4, 5, 6, 7), p1, O[db]); } }
#pragma unroll
                    for (int db = 0; db < 2; ++db)
#pragma unroll
                        for (int i = 0; i < 16; ++i) O[db][i] *= gt0;
                    { bf16_t* orow = MIX + m * 2048 + 1024 + hd * 64 + 4 * h;
#pragma unroll
                      for (int db = 0; db < 2; ++db)
#pragma unroll
                          for (int q = 0; q < 4; ++q) { u32x2 w; w.x = cvt2(O[db][4 * q], O[db][4 * q + 1]); w.y = cvt2(O[db][4 * q + 2], O[db][4 * q + 3]); *(u32x2*)(orow + db * 32 + 8 * q) = w; } }
#pragma unroll
                    for (int db = 0; db < 2; ++db)
#pragma unroll
                        for (int i = 0; i < 16; ++i) O[db][i] = 0.f;
                    float imp[16], tl[16];
#pragma unroll
                    for (int k = 0; k < 16; ++k) { const f32x16& T = S[k >> 2]; const int q = (k & 3) * 4; tl[k] = T[q + 3]; imp[k] = (T[q] + T[q + 1]) + (T[q + 2] + 0.5f * T[q + 3]); }
#pragma unroll
                    for (int k = 0; k < 16; ++k) tl[k] = xor32(tl[k]);
#pragma unroll
                    for (int k = 0; k < 16; ++k) { const float prev = h ? tl[k] : (k > 0 ? tl[k > 0 ? k - 1 : 0] : 0.f); float x = imp[k] + 0.5f * prev; x += __shfl_xor(x, 8); x += __shfl_xor(x, 16); imp[k] = x; }
                    float sc[16], sp[16];
#pragma unroll
                    for (int k = 0; k < 16; ++k) { const int j = 2 * k + h; sc[k] = (j == 0 || j == 31) ? INFINITY : imp[k]; }
#pragma unroll
                    for (int k = 0; k < 16; ++k) sp[k] = xor32(sc[k]);
                    unsigned own = 0u;
#pragma unroll
                    for (int k = 0; k < 16; ++k) { int rank = 0; const float me = sc[k];
#pragma unroll
                        for (int q = 0; q < 16; ++q) { if (q < k) rank += (sc[q] >= me) ? 1 : 0; else if (q > k) rank += (sc[q] > me) ? 1 : 0;
                            if (q < k) rank += (sp[q] >= me) ? 1 : 0; else if (q > k) rank += (sp[q] > me) ? 1 : 0; else rank += (h ? (sp[q] >= me) : (sp[q] > me)) ? 1 : 0; }
                        if (rank < 15) own |= 1u << (2 * k + h); }
                    rowmask = own | (unsigned)__shfl_xor((int)own, 32);
                }
                    unsigned wm = rowmask; wm |= (unsigned)__shfl_xor((int)wm, 1); wm |= (unsigned)__shfl_xor((int)wm, 2); wm |= (unsigned)__shfl_xor((int)wm, 4);
                    rem = (unsigned)__builtin_amdgcn_readfirstlane((int)wm);
                    if (lane < 32) mk[lane] = rowmask; if (lane == 0) mk[32] = rem; LDS_WAIT(); if (lane == 0) mk[33] = tag;
                } else {
                    while (mk[33] != tag) __builtin_amdgcn_s_sleep(2);
                    rowmask = mk[r32]; rem = (unsigned)__builtin_amdgcn_readfirstlane((int)mk[32]);
                }
                int j = -1;
                { int ord = 0; while (rem) { const int jj = __builtin_ctz(rem); rem &= rem - 1; if (((ord++) & 1) == role) { j = jj; break; } } if ((ord & 1) == 0 && j >= 0 && role == 0) {} }
                if (j >= 0) { RawT ra; int sub = 0;
                    const float* base = p.cache_kv + ((size_t)p.page_table[b * 16 + (j >> 1)] * 128 + (j & 1) * 64) * 1024 + g * 64;
                    raw_load(ra, base + 512, base + 768, 1024, r32, h, lane);
#pragma unroll 1
                    for (;;) { const bool rs = ((rowmask >> j) & 1u) != 0u; const int d0 = qpos - 4 * h - (64 * j + 32 * sub);
                        raw_use(ra, vt, r32, h, lane, kf, va);
                        bool more = true;
                        if (sub == 0) { sub = 1; base += 32 * 1024; }
                        else { if (rem) rem &= rem - 1;
                            if (rem) { j = __builtin_ctz(rem); rem &= rem - 1; sub = 0; base = p.cache_kv + ((size_t)p.page_table[b * 16 + (j >> 1)] * 128 + (j & 1) * 64) * 1024 + g * 64; } else more = false; }
                        if (more) raw_load(ra, base + 512, base + 768, 1024, r32, h, lane);
                        attn_sub32<1>(kf, va, qf, d0, rs, slope2, mrun, lrun, O);
                        if (!more) break; } }
                if (role == 0) {
                    load_new_rows(KSLC, VSLC, m0, g, r32, h, kf, va);
                    attn_sub32<1>(kf, va, qf, ti - 4 * h, true, slope2, mrun, lrun, O);
                    gsel = gt1;
                } else {
#pragma unroll
                    for (int db = 0; db < 2; ++db)
#pragma unroll
                        for (int i = 0; i < 16; ++i) part[64 * (db * 16 + i)] = O[db][i];
                    part[64 * 32] = mrun; part[64 * 33] = lrun;
                }
            }
        }
        asm volatile("s_waitcnt vmcnt(0)" ::: "memory"); __syncthreads();
        if (active && role == 0) {
            { const float mC = part[64 * 32], lC = part[64 * 33], M = fmaxf(mrun, mC), sA = __builtin_amdgcn_exp2f(mrun - M), sC = __builtin_amdgcn_exp2f(mC - M);
              const float lt = lrun * sA + lC * sC; const float inv = gsel / fmaxf(lt + xor32(lt), 1e-30f);
#pragma unroll
              for (int db = 0; db < 2; ++db)
#pragma unroll
                  for (int i = 0; i < 16; ++i) O[db][i] = inv * (O[db][i] * sA + part[64 * (db * 16 + i)] * sC); }
            bf16_t* orow = MIX + m * 2048 + 1024 + hd * 64 + 4 * h;
#pragma unroll
            for (int db = 0; db < 2; ++db)
#pragma unroll
                for (int q = 0; q < 4; ++q) { const f32x4 xb = *(const LAS f32x4*)(XR + (ul * 64 + lane) * 32 + db * 16 + q * 4);
                    const u32x2 cw = *(const u32x2*)(orow + db * 32 + 8 * q);
                    u32x2 w; w.x = cvt2(O[db][4 * q] + xb.x + __uint_as_float(cw.x << 16), O[db][4 * q + 1] + xb.y + __uint_as_float(cw.x & 0xffff0000u)); w.y = cvt2(O[db][4 * q + 2] + xb.z + __uint_as_float(cw.y << 16), O[db][4 * q + 3] + xb.w + __uint_as_float(cw.y & 0xffff0000u)); *(u32x2*)(orow + db * 32 + 8 * q) = w; }
        }
        __syncthreads();
    }
}

DI void phase_ret_kv_mfma(const P& p, int bid, int G) {
    int tid = mk_tid(p.hi); const int lane = tid & 63, wave = tid >> 6, r32 = lane & 31, h = lane >> 5; unsigned char* ws = p.ws;
    const bf16_t *RKT = (const bf16_t*)(ws + WS_RKT), *RVT = (const bf16_t*)(ws + WS_RVT); float* KVT = (float*)(ws + WS_KVT);
    const int e0 = 64 * (wave >> 1);
#pragma unroll 1
    for (int it = bid * 2; it < 512; it += G * 2) {
#pragma unroll 1
      for (int dq = 0; dq < 2; ++dq) {
        const int unit = it >> 1, d0 = 128 * (wave & 1) + 64 * dq, bh = unit >> 4, c = unit & 15;
        const bf16_t* va = RVT + ((size_t)bh * 256 + e0 + r32) * 2048 + c * 128 + 8 * h; const bf16_t* kb = RKT + ((size_t)bh * 256 + d0 + r32) * 2048 + c * 128 + 8 * h;
        f32x16 acc[2][2];
#pragma unroll
        for (int a = 0; a < 2; ++a)
#pragma unroll
            for (int q = 0; q < 2; ++q)
#pragma unroll
                for (int i = 0; i < 16; ++i) acc[a][q][i] = 0.f;
#pragma unroll
        for (int s = 0; s < 8; ++s) { bf16x8 af[2], bf[2];
#pragma unroll
            for (int a = 0; a < 2; ++a) af[a] = *(const bf16x8*)(va + (size_t)a * 32 * 2048 + s * 16);
#pragma unroll
            for (int q = 0; q < 2; ++q) bf[q] = *(const bf16x8*)(kb + (size_t)q * 32 * 2048 + s * 16);
#pragma unroll
            for (int a = 0; a < 2; ++a)
#pragma unroll
                for (int q = 0; q < 2; ++q) acc[a][q] = MFMA32(af[a], bf[q], acc[a][q]); }
#pragma unroll
        for (int a = 0; a < 2; ++a)
#pragma unroll
            for (int q = 0; q < 2; ++q) { float* o = KVT + (size_t)unit * 65536 + (size_t)(e0 + 32 * a + 4 * h) * 256 + d0 + 32 * q + r32;
#pragma unroll
                for (int i = 0; i < 16; ++i) o[((i & 3) + 8 * (i >> 2)) * 256] = acc[a][q][i];
                asm volatile("" ::: "memory"); }
      }
    }
}
DI void phase_ret_scan_t(const P& p, int bid, int G) {
    int tid = mk_tid(p.hi); unsigned char* ws = p.ws;
    const float* KVT = (const float*)(ws + WS_KVT); bf16_t* SSTT = (bf16_t*)(ws + WS_SSTT);
    for (int i = bid * 512 + tid; i < 16 * 16384; i += G * 512) {
        const int bh = i >> 14, q = (i & 16383) * 4, e = q >> 8, d = q & 255; const float gc = exp2f(gamma_log2(bh & 3) * 128.f);
        f32x4 S = (f32x4){0.f, 0.f, 0.f, 0.f}, kv[16];
#pragma unroll
        for (int c = 0; c < 16; ++c) kv[c] = *(const f32x4*)(KVT + ((size_t)bh * 16 + c) * 65536 + q);
#pragma unroll
        for (int c = 0; c < 16; ++c) { *(u32x2*)(SSTT + ((size_t)bh * 16 + c) * 65536 + q) = (u32x2){cvt2(S[0], S[1]), cvt2(S[2], S[3])}; S = (S + kv[c]) * gc; }
        float* o = p.out + O_RETP + (size_t)bh * 65536 + e;
#pragma unroll
        for (int k = 0; k < 4; ++k) o[(size_t)(d + k) * 256] = S[k];
    }
}
DI void phase_ret_out_mfma(const P& p, LAS unsigned char* lds, int bid, int G) {
    int tid = mk_tid(p.hi); const int lane = tid & 63, wave = tid >> 6, r32 = lane & 31, h = lane >> 5, tq = wave & 3, eh = wave >> 2; unsigned char* ws = p.ws;
    const bf16_t *RQ = (const bf16_t*)(ws + WS_RQ), *RK = (const bf16_t*)(ws + WS_RK), *RVT = (const bf16_t*)(ws + WS_RVT), *SSTT = (const bf16_t*)(ws + WS_SSTT), *RGS = (const bf16_t*)(ws + WS_RGS);
    bf16_t* MIX = (bf16_t*)(ws + WS_MIX); LAS float* SS = (LAS float*)lds;
#pragma unroll 1
    for (int unit = bid; unit < 256; unit += G) {
        const int bh = unit >> 4, b = bh >> 2, hh = bh & 3, c = unit & 15; const size_t m0 = (size_t)b * 2048 + c * 128;
        bf16x8 qf[16];
#pragma unroll
        for (int s = 0; s < 16; ++s) qf[s] = *(const bf16x8*)(RQ + (m0 + 32 * tq + r32) * 1024 + hh * 256 + 16 * s + 8 * h);
        f32x16 O[4];
#pragma unroll
        for (int eb = 0; eb < 4; ++eb)
#pragma unroll
            for (int i = 0; i < 16; ++i) O[eb][i] = 0.f;
        const bf16_t* vt = RVT + ((size_t)bh * 256 + 128 * eh + r32) * 2048 + c * 128 + 4 * h;
#pragma unroll 1
        for (int jb = 0; jb <= tq; ++jb) {
            f32x16 S;
#pragma unroll
            for (int i = 0; i < 16; ++i) S[i] = 0.f;
            const bf16_t* kr = RK + (m0 + 32 * jb + r32) * 1024 + hh * 256 + 8 * h;
            s16x4 vf[4][4];
#pragma unroll
            for (int eb = 0; eb < 4; ++eb) { const bf16_t* vr = vt + (size_t)eb * 32 * 2048 + 32 * jb;
#pragma unroll
                for (int q = 0; q < 4; ++q) vf[eb][q] = *(const s16x4*)(vr + 8 * q); }
            bf16x8 kfr[16];
#pragma unroll
            for (int s = 0; s < 16; ++s) kfr[s] = *(const bf16x8*)(kr + 16 * s);
            asm volatile("" ::: "memory");
#pragma unroll
            for (int s = 0; s < 16; ++s) S = MFMA32(kfr[s], qf[s], S);
            if (jb == tq) {
#pragma unroll
                for (int i = 0; i < 16; ++i) if ((i & 3) + 8 * (i >> 2) + 4 * h > r32) S[i] = 0.f;
            }
            const bf16x8 p0 = pack_step<0>(S), p1 = pack_step<1>(S);
#pragma unroll
            for (int eb = 0; eb < 4; ++eb) { const s16x4 a0 = vf[eb][0], a1 = vf[eb][1], b0 = vf[eb][2], b1 = vf[eb][3];
                O[eb] = MFMA32(__builtin_shufflevector(a0, a1, 0, 1, 2, 3, 4, 5, 6, 7), p0, O[eb]); O[eb] = MFMA32(__builtin_shufflevector(b0, b1, 0, 1, 2, 3, 4, 5, 6, 7), p1, O[eb]); }
        }
        { const bf16_t* st = SSTT + (size_t)unit * 65536 + (size_t)(128 * eh + r32) * 256 + 8 * h;
#pragma unroll
          for (int s0 = 0; s0 < 16; s0 += 4) { bf16x8 sf[4][4];
#pragma unroll
              for (int j = 0; j < 4; ++j)
#pragma unroll
                  for (int eb = 0; eb < 4; ++eb) sf[j][eb] = *(const bf16x8*)(st + (size_t)eb * 32 * 256 + 16 * (s0 + j));
              asm volatile("" ::: "memory");
#pragma unroll
              for (int j = 0; j < 4; ++j)
#pragma unroll
                  for (int eb = 0; eb < 4; ++eb) O[eb] = MFMA32(sf[j][eb], qf[s0 + j], O[eb]); } }
        float ss = 0.f;
#pragma unroll
        for (int eb = 0; eb < 4; ++eb)
#pragma unroll
            for (int i = 0; i < 16; ++i) ss += O[eb][i] * O[eb][i];
        ss += xor32(ss);
        __syncthreads();
        if (h == 0) SS[(eh * 4 + tq) * 32 + r32] = ss;
        __syncthreads();
        const float r = rsqrtf((SS[tq * 32 + r32] + SS[(4 + tq) * 32 + r32]) * (1.f / 256.f) + EPS);
        const size_t m = m0 + 32 * tq + r32; const int ec = hh * 256 + 128 * eh + 4 * h;
#pragma unroll
        for (int eb = 0; eb < 4; ++eb)
#pragma unroll
            for (int q4 = 0; q4 < 4; ++q4) { const int e = ec + 32 * eb + 8 * q4; const u32x2 rgb = *(const u32x2*)(RGS + m * 1024 + e); const f32x4 gn = *(const f32x4*)(p.ret_gn + e);
                u32x2 w; w.x = cvt2(O[eb][4 * q4] * r * gn[0] * __uint_as_float(rgb.x << 16), O[eb][4 * q4 + 1] * r * gn[1] * __uint_as_float(rgb.x & 0xffff0000u));
                w.y = cvt2(O[eb][4 * q4 + 2] * r * gn[2] * __uint_as_float(rgb.y << 16), O[eb][4 * q4 + 3] * r * gn[3] * __uint_as_float(rgb.y & 0xffff0000u));
                *(u32x2*)(MIX + m * 2048 + e) = w; }
    }
}


typedef pg8::Unit Unit;
#define EPI_ARGS const f32x4 (&acc)[2][2][4][2], const Unit& u, int wr, int wc, int fr, int fq
struct EpiZ { static constexpr bool PERM = false, AFTER_DRAIN = false; float* Zp; const float* rstd;
    DI void operator()(EPI_ARGS) const {
        const int row0 = u.pm * 256 + wr * 64 + fr, col0 = u.pn * 256 + wc * 32 + 4 * fq;
#pragma unroll
        for (int ai = 0; ai < 2; ++ai)
#pragma unroll
            for (int m = 0; m < 4; ++m) { const int r = row0 + ai * 128 + m * 16; const float s = rstd[r]; float* rowp = Zp + (size_t)r * DINP + col0;
#pragma unroll
                for (int bj = 0; bj < 2; ++bj)
#pragma unroll
                    for (int n = 0; n < 2; ++n) *(f32x4*)(rowp + bj * 128 + n * 16) = acc[ai][bj][m][n] * s; }
    } };

DI u32x2 pk4(const f32x4& v) { u32x2 w; w.x = pg8::cvt_pk_bf16(v[0], v[1]); w.y = pg8::cvt_pk_bf16(v[2], v[3]); return w; }
DI u32x4 pk8(const float (&y)[8]) { u32x4 w; w.x = pg8::cvt_pk_bf16(y[0], y[1]); w.y = pg8::cvt_pk_bf16(y[2], y[3]); w.z = pg8::cvt_pk_bf16(y[4], y[5]); w.w = pg8::cvt_pk_bf16(y[6], y[7]); return w; }
struct EpiProj { static constexpr bool PERM = false, AFTER_DRAIN = false;
    const float* rstd; const float* SCf; float* out; unsigned char* ws;
    DI void operator()(const f32x4 (&acc)[2][2][4][2], const pg8::Unit2& u, int wr, int wc, int fr0, int fq0) const {
        int fr = fr0, fq = fq0; asm volatile("" : "+v"(fr), "+v"(fq));
        const int pn = u.pn, tok0 = u.pm * 256 + wr * 128 + fr * 8; const bool prompt = u.pm < 32;
        const int b = prompt ? (tok0 >> 11) : ((tok0 - NP) >> 3), t0 = prompt ? (tok0 & 2047) : 0;
        float rs[8];
#pragma unroll
        for (int j = 0; j < 8; ++j) rs[j] = rstd[tok0 + j];
        if (pn < 8) {
            const int hh = pn & 3; const bool isk = pn >= 4; const float lg = log2f(1.f - exp2f(-5.f - (float)hh)) * (isk ? -1.f : 1.f);
            bf16_t* dst = (bf16_t*)(ws + (isk ? WS_RK : WS_RQ)) + hh * 256 + wc * 32 + 4 * fq; const int ic0 = prompt ? (t0 & 127) : 0, pos0 = prompt ? t0 : 2048;
#pragma unroll
            for (int j = 0; j < 8; ++j) rs[j] *= exp2f(lg * (float)(ic0 + j + 1)) * (isk ? 0.0625f : 1.f);
#pragma unroll
            for (int n = 0; n < 2; ++n) {
                float y1[4][8], y2[4][8];
#pragma unroll
                for (int j = 0; j < 8; ++j) { const float* scp = SCf + ((size_t)(pos0 + j) * 128 + wc * 32 + n * 16 + 4 * fq) * 2; const f32x4 ca = *(const f32x4*)scp, cb = *(const f32x4*)(scp + 4);
                    const f32x4 x1 = acc[j >> 2][0][j & 3][n] * rs[j], x2 = acc[j >> 2][1][j & 3][n] * rs[j];
                    y1[0][j] = x1[0] * ca[0] - x2[0] * ca[1]; y1[1][j] = x1[1] * ca[2] - x2[1] * ca[3]; y1[2][j] = x1[2] * cb[0] - x2[2] * cb[1]; y1[3][j] = x1[3] * cb[2] - x2[3] * cb[3];
                    y2[0][j] = x2[0] * ca[0] + x1[0] * ca[1]; y2[1][j] = x2[1] * ca[2] + x1[1] * ca[3]; y2[2][j] = x2[2] * cb[0] + x1[2] * cb[1]; y2[3][j] = x2[3] * cb[2] + x1[3] * cb[3];
                    *(u32x2*)(dst + (size_t)(tok0 + j) * 1024 + n * 16) = pk4((f32x4){y1[0][j], y1[1][j], y1[2][j], y1[3][j]});
                    *(u32x2*)(dst + (size_t)(tok0 + j) * 1024 + 128 + n * 16) = pk4((f32x4){y2[0][j], y2[1][j], y2[2][j], y2[3][j]}); }
                if (isk && prompt) {
                    bf16_t* dt = (bf16_t*)(ws + WS_RKT) + ((size_t)(b * 4 + hh) * 256 + wc * 32 + n * 16 + 4 * fq) * 2048 + t0;
#pragma unroll
                    for (int e = 0; e < 4; ++e) { *(u32x4*)(dt + (size_t)e * 2048) = pk8(y1[e]); *(u32x4*)(dt + (size_t)(128 + e) * 2048) = pk8(y2[e]); } }
                asm volatile("" ::: "memory");
            }
        } else if (pn < 16) {
            const int hh = pn & 3; const bool gate = pn >= 12;
            bf16_t* dst = (bf16_t*)(ws + (gate ? WS_RGS : WS_RV)) + hh * 256 + wc * 32 + 4 * fq;
            if (gate || !prompt)
#pragma unroll
            for (int j = 0; j < 8; ++j)
#pragma unroll
                for (int bj = 0; bj < 2; ++bj)
#pragma unroll
                    for (int n = 0; n < 2; ++n) { f32x4 v = acc[j >> 2][bj][j & 3][n] * rs[j]; if (gate) v = (f32x4){silu_f(v[0]), silu_f(v[1]), silu_f(v[2]), silu_f(v[3])};
                        *(u32x2*)(dst + (size_t)(tok0 + j) * 1024 + bj * 128 + n * 16) = pk4(v); }
            if (!gate && prompt) {
                const int fqo = fq;
                bf16_t* dt = (bf16_t*)(ws + WS_RVT) + ((size_t)(b * 4 + hh) * 256 + wc * 32 + 4 * fqo) * 2048 + t0;
#pragma unroll
                for (int bj = 0; bj < 2; ++bj)
#pragma unroll
                    for (int n = 0; n < 2; ++n)
#pragma unroll
                        for (int e = 0; e < 4; ++e) { float y[8];
#pragma unroll
                            for (int j = 0; j < 8; ++j) y[j] = acc[j >> 2][bj][j & 3][n][e] * rs[j];
                            *(u32x4*)(dt + (size_t)(bj * 128 + n * 16 + e) * 2048) = pk8(y); asm volatile("" ::: "memory"); } }
        } else if (pn < 26) {
            const int slot = pn - 20; const bool norm = slot < 0 || slot == 2 || slot == 4; const float* gvec = (const float*)(ws + WS_NORMS) + (slot < 0 ? 0 : (slot >> 1) * 64);
            f32x4 gv[2][2];
#pragma unroll
            for (int bj = 0; bj < 2; ++bj)
#pragma unroll
                for (int n = 0; n < 2; ++n) gv[bj][n] = norm ? *(const f32x4*)(gvec + 32 * bj + 16 * n + 4 * fq) : (f32x4){1.f, 1.f, 1.f, 1.f};
            bf16_t *NQ = (bf16_t*)(ws + WS_NQ), *CBU = (bf16_t*)(ws + WS_CBU);
            const int s2i = slot >= 2 ? slot - 2 : 0;
            bf16_t* tokb = (bf16_t*)(ws + WS_KSLC + (size_t)s2i * ((size_t)MT * 512));
            bf16_t* seqb = (bf16_t*)(ws + WS_KSP + (size_t)s2i * 4194304);
#pragma unroll
            for (int j = 0; j < 8; ++j) { const int r = tok0 + j, t = prompt ? t0 + j : j;
                f32x4 v[2][2]; float ss = 0.f;
#pragma unroll
                for (int bj = 0; bj < 2; ++bj)
#pragma unroll
                    for (int n = 0; n < 2; ++n) { v[bj][n] = acc[j >> 2][bj][j & 3][n] * rs[j]; ss += (v[bj][n][0] * v[bj][n][0] + v[bj][n][1] * v[bj][n][1]) + (v[bj][n][2] * v[bj][n][2] + v[bj][n][3] * v[bj][n][3]); }
                if (norm) { ss += __shfl_xor(ss, 16); ss += __shfl_xor(ss, 32); const float rn = rsqrtf(ss * (1.f / 64.f) + EPS) * (slot < 0 ? 0.125f : 1.f);
#pragma unroll
                    for (int bj = 0; bj < 2; ++bj)
#pragma unroll
                        for (int n = 0; n < 2; ++n) v[bj][n] = v[bj][n] * rn * gv[bj][n]; }
#pragma unroll
                for (int bj = 0; bj < 2; ++bj)
#pragma unroll
                    for (int n = 0; n < 2; ++n) { const int d = 32 * bj + 16 * n + 4 * fq; const f32x4 x = v[bj][n]; const u32x2 xb = pk4(x);
                        if (slot < 0) { *(u32x2*)(NQ + (size_t)r * 1024 + ((pn - 16) * 4 + wc) * 64 + d) = xb; continue; }
                        if (slot < 4) *(f32x4*)(out + O_KV + (size_t)r * 1024 + slot * 256 + wc * 64 + d) = x;
                        if (slot < 2) { if (prompt) *(u32x2*)(CBU + ((((size_t)slot * NBB + b) * 4 + wc) * 2048 + t) * 64 + d) = xb; continue; }
                        if (!prompt) *(u32x2*)(tokb + (size_t)r * 256 + wc * 64 + d) = xb;
                        if (prompt && (slot == 2 || slot == 4)) *(u32x2*)(seqb + (((size_t)b * 4 + wc) * 2048 + t) * 64 + d) = xb;
                        if (slot >= 4) { if (prompt) { if (t >= 1536) *(f32x4*)(out + O_WINP + (((size_t)b * 512 + (t - 1536)) * 2 + (slot - 4)) * 256 + wc * 64 + d) = x; }
                            else *(f32x4*)(out + O_WINS + (((size_t)b * 512 + 504 + t) * 2 + (slot - 4)) * 256 + wc * 64 + d) = x; } } }
            if (prompt && (slot == 3 || slot == 5)) {
                const int fqo = fq;
                bf16_t* dt = seqb + (((size_t)b * 4 + wc) * 64 + 4 * fqo) * 2048 + t0;
#pragma unroll
                for (int bj = 0; bj < 2; ++bj)
#pragma unroll
                    for (int n = 0; n < 2; ++n)
#pragma unroll
                        for (int e = 0; e < 4; ++e) { float y[8];
#pragma unroll
                            for (int j = 0; j < 8; ++j) y[j] = acc[j >> 2][bj][j & 3][n][e] * rs[j];
                            *(u32x4*)(dt + (size_t)(32 * bj + 16 * n + e) * 2048) = pk8(y); asm volatile("" ::: "memory"); } }
        } else {
            float* GATES = (float*)(ws + WS_GATES);
#pragma unroll
            for (int j = 0; j < 8; ++j)
#pragma unroll
                for (int n = 0; n < 2; ++n) { const int c = wc * 32 + n * 16 + 4 * fq; if (c < 48) { const f32x4 v = acc[j >> 2][0][j & 3][n] * rs[j]; *(f32x4*)(GATES + (size_t)(tok0 + j) * 48 + c) = (f32x4){sigmoid_f(v[0]), sigmoid_f(v[1]), sigmoid_f(v[2]), sigmoid_f(v[3])}; } }
        }
    } };
struct ProjOrder { int G, c, i0, i1;
    DI bool next(int i, pg8::Unit2& u) const { if (i0 + i >= i1) return false; pg8::StaticOrder so; so.init(MT, DINP, G, c); pg8::Unit t; if (!so.next(i0 + i, t)) return false; u.pm = t.pm; u.pn = t.pn; u.kt0 = 0; u.nt = D / 64; return true; }
};
struct EpiHpre { static constexpr bool PERM = true, AFTER_DRAIN = false; bf16_t* Hp;
    DI void operator()(EPI_ARGS) const {
        const int row0 = u.pm * 256 + wr * 64 + fr, col0 = (u.pn & 1) * 256 + wc * 32 + 8 * fq;
#pragma unroll
        for (int ai = 0; ai < 2; ++ai)
#pragma unroll
            for (int m = 0; m < 4; ++m) { bf16_t* rowp = Hp + (size_t)(row0 + ai * 128 + m * 16) * 512 + col0;
#pragma unroll
                for (int bj = 0; bj < 2; ++bj) { const f32x4 v0 = acc[ai][bj][m][0], v1 = acc[ai][bj][m][1]; u32x4 w;
                    w.x = pg8::cvt_pk_bf16(v0[0], v0[1]); w.y = pg8::cvt_pk_bf16(v0[2], v0[3]); w.z = pg8::cvt_pk_bf16(v1[0], v1[1]); w.w = pg8::cvt_pk_bf16(v1[2], v1[3]);
                    *(u32x4*)(rowp + bj * 128) = w; } }
    } };
struct EpiOut { static constexpr bool PERM = false, AFTER_DRAIN = false; const float *xp, *xs, *gf; float* H; bf16_t* HG; float* rowss; float* SLAB;
    DI void operator()(const f32x4 (&acc)[2][2][4][2], const pg8::Unit2& u, int wr, int wc, int fr, int fq) const {
        const int row0 = u.pm * 256 + wr * 64 + fr, col0 = u.pn * 256 + wc * 32 + 4 * fq;
        if (u.nt != D / 64) {
#pragma unroll
            for (int ai = 0; ai < 2; ++ai)
#pragma unroll
                for (int m = 0; m < 4; ++m) { float* sp = SLAB + (size_t)(u.kt0 / 4) * NS * D + (size_t)(row0 + ai * 128 + m * 16 - NP) * D + col0;
#pragma unroll
                    for (int bj = 0; bj < 2; ++bj)
#pragma unroll
                        for (int n = 0; n < 2; ++n) *(f32x4*)(sp + bj * 128 + n * 16) = acc[ai][bj][m][n]; }
            return; }
        f32x4 gv[2][2];
#pragma unroll
        for (int bj = 0; bj < 2; ++bj)
#pragma unroll
            for (int n = 0; n < 2; ++n) gv[bj][n] = *(const f32x4*)(gf + col0 + bj * 128 + n * 16);
#pragma unroll
        for (int ai = 0; ai < 2; ++ai)
#pragma unroll
            for (int m = 0; m < 4; ++m) { const int r = row0 + ai * 128 + m * 16; const float* xr = (r < NP ? xp + (size_t)r * D : xs + (size_t)(r - NP) * D) + col0; float ss = 0.f;
#pragma unroll
                for (int bj = 0; bj < 2; ++bj)
#pragma unroll
                    for (int n = 0; n < 2; ++n) { const f32x4 h = *(const f32x4*)(xr + bj * 128 + n * 16) + acc[ai][bj][m][n];
                        *(f32x4*)(H + (size_t)r * D + col0 + bj * 128 + n * 16) = h; ss += (h[0] * h[0] + h[1] * h[1]) + (h[2] * h[2] + h[3] * h[3]);
                        const f32x4 hg = h * gv[bj][n]; u32x2 w; w.x = pg8::cvt_pk_bf16(hg[0], hg[1]); w.y = pg8::cvt_pk_bf16(hg[2], hg[3]);
                        *(u32x2*)(HG + (size_t)r * D + col0 + bj * 128 + n * 16) = w; }
                ss += __shfl_xor(ss, 16); ss += __shfl_xor(ss, 32);
                if (fq == 0) atomicAdd(rowss + r, ss); }
    } };
struct OutOrder { int G, c;
    DI bool next(int i, pg8::Unit2& u) const { const long L = (long)i * G + c;
        if (L < 256) { pg8::StaticOrder so; so.init(NP, D, 1, (int)L); pg8::Unit t; so.next(0, t); u.pm = t.pm; u.pn = t.pn; u.kt0 = 0; u.nt = D / 64; return true; }
        if (L < 512) { const int q = (int)L - 256, tile = q >> 3, ks = q & 7; u.pm = 32 + (tile >> 3); u.pn = tile & 7; u.kt0 = ks * 4; u.nt = 4; return true; }
        return false; }
};
DI void phase_out_reduce(const P& p, int bid, int G) {
    int tid = mk_tid(p.hi); const int lane = tid & 63, wave = tid >> 6; unsigned char* ws = p.ws;
    const float* SL = (const float*)(ws + WS_SLAB); float* H = (float*)(ws + WS_H); bf16_t* HG = (bf16_t*)(ws + WS_HG); float* rowss = (float*)(ws + CTL_ROWSS);
    for (int it = bid * 8 + wave; it < NS * 2; it += G * 8) { const int r = it >> 1, j0 = (it & 1) * 4; float ss = 0.f;
#pragma unroll
        for (int j = j0; j < j0 + 4; ++j) { const size_t o = (size_t)r * D + (j * 64 + lane) * 4;
            f32x4 h = *(const f32x4*)(p.x_sample + o);
#pragma unroll
            for (int k = 0; k < 8; ++k) h += *(const f32x4*)(SL + (size_t)k * NS * D + o);
            *(f32x4*)(H + (size_t)NP * D + o) = h; ss += (h[0] * h[0] + h[1] * h[1]) + (h[2] * h[2] + h[3] * h[3]);
            const f32x4 hg = h * *(const f32x4*)(p.g_ffn + (j * 64 + lane) * 4); u32x2 w; w.x = pg8::cvt_pk_bf16(hg[0], hg[1]); w.y = pg8::cvt_pk_bf16(hg[2], hg[3]);
            *(u32x2*)(HG + (size_t)NP * D + o) = w; }
        ss = wave_sum(ss); if (lane == 0) atomicAdd(rowss + NP + r, ss); }
}
struct EpiUp { static constexpr bool PERM = true, AFTER_DRAIN = false; bf16_t* U; const float* rowss; float* out;
    DI void operator()(EPI_ARGS) const {
        const int row0 = u.pm * 256 + wr * 64 + fr, col0 = u.pn * 256 + wc * 32 + 8 * fq;
#pragma unroll
        for (int ai = 0; ai < 2; ++ai)
#pragma unroll
            for (int m = 0; m < 4; ++m) { const int r = row0 + ai * 128 + m * 16; const float s = rsqrtf(rowss[r] * (1.f / D) + EPS);
                float* cs = nullptr;
                if (r < NP) { const int t = r & 2047; if (t >= 2046) cs = out + O_CONVP + ((size_t)(r >> 11) * 2 + (t - 2046)) * FF2; }
                else { const int t = (r - NP) & 7; if (t >= 6) cs = out + O_CONVS + ((size_t)((r - NP) >> 3) * 2 + (t - 6)) * FF2; }
#pragma unroll
                for (int bj = 0; bj < 2; ++bj) { const f32x4 v0 = acc[ai][bj][m][0] * s, v1 = acc[ai][bj][m][1] * s; u32x4 w;
                    w.x = pg8::cvt_pk_bf16(v0[0], v0[1]); w.y = pg8::cvt_pk_bf16(v0[2], v0[3]); w.z = pg8::cvt_pk_bf16(v1[0], v1[1]); w.w = pg8::cvt_pk_bf16(v1[2], v1[3]);
                    *(u32x4*)(U + (size_t)r * FF2 + col0 + bj * 128) = w;
                    if (cs) { *(f32x4*)(cs + col0 + bj * 128) = v0; *(f32x4*)(cs + col0 + bj * 128 + 4) = v1; } } }
    } };

DI f32x4 dpp_shr1(const f32x4& v) { f32x4 r;
#pragma unroll
    for (int e = 0; e < 4; ++e) r[e] = __int_as_float(__builtin_amdgcn_update_dpp(0, __float_as_int(v[e]), 0x111, 0xf, 0xf, false));
    return r; }
DI f32x4 silu4(const f32x4& v) { return (f32x4){silu_f(v[0]), silu_f(v[1]), silu_f(v[2]), silu_f(v[3])}; }
struct EpiUpConv { static constexpr bool PERM = false, AFTER_DRAIN = false; bf16_t* ACT; const float* rowss; const float *conv_w, *conv_b, *state_conv; float* out; float* UX;
    DI void operator()(const f32x4 (&acc)[2][2][4][2], const pg8::Unit2& u, int wr, int wc, int fr, int fq) const {
        const bool prompt = u.pm < 32; const int tok0 = u.pm * 256 + wr * 128 + fr * 8;
        float rs[8];
#pragma unroll
        for (int j = 0; j < 8; ++j) rs[j] = rsqrtf(rowss[tok0 + j] * (1.f / D) + EPS);
        const int sb = (tok0 - NP) >> 3;
        const bool cstate = prompt ? ((u.pm & 7) == 7 && wr == 1 && fr == 15) : true;
        float* cso = prompt ? out + O_CONVP + (size_t)(u.pm >> 3) * 2 * FF2 : out + O_CONVS + (size_t)sb * 2 * FF2;
#pragma unroll
        for (int n = 0; n < 2; ++n) {
            const int q = wc * 32 + n * 16 + fq * 4, ca = u.pn * 128 + q;
            f32x4 cv[8];
#pragma unroll
            for (int hf = 0; hf < 2; ++hf) {
                const int col = ca + hf * FF;
                const f32x4 w0 = *(const f32x4*)(conv_w + col), w1 = *(const f32x4*)(conv_w + FF2 + col), w2 = *(const f32x4*)(conv_w + 2 * FF2 + col), cb = *(const f32x4*)(conv_b + col);
                f32x4 uu[8];
#pragma unroll
                for (int j = 0; j < 8; ++j) uu[j] = acc[j >> 2][hf][j & 3][n] * rs[j];
                f32x4 p1, p2;
                if (prompt) { p1 = dpp_shr1(uu[7]); p2 = dpp_shr1(uu[6]); }
                else { p1 = *(const f32x4*)(state_conv + ((size_t)sb * 2 + 1) * FF2 + col); p2 = *(const f32x4*)(state_conv + (size_t)sb * 2 * FF2 + col); }
                if (cstate) { *(f32x4*)(cso + col) = uu[6]; *(f32x4*)(cso + FF2 + col) = uu[7]; }
                if (prompt && fr == 15) { float* ux = UX + ((size_t)u.pm * 8 + 2 * wr) * FF2 + col; *(f32x4*)ux = uu[6]; *(f32x4*)(ux + FF2) = uu[7]; }
                if (prompt && fr == 0) { float* ux = UX + ((size_t)u.pm * 8 + 4 + 2 * wr) * FF2 + col; *(f32x4*)ux = uu[0]; *(f32x4*)(ux + FF2) = uu[1]; }
#pragma unroll
                for (int j = 0; j < 8; ++j) { const f32x4 um1 = j >= 1 ? uu[j >= 1 ? j - 1 : 0] : p1, um2 = j >= 2 ? uu[j >= 2 ? j - 2 : 0] : (j == 1 ? p1 : p2);
                    const f32x4 c = cb + w2 * uu[j] + w1 * um1 + w0 * um2;
                    if (hf == 0) cv[j] = silu4(c); else cv[j] = cv[j] * c; }
            }
#pragma unroll
            for (int j = 0; j < 8; ++j) if (!(prompt && fr == 0 && j < 2)) *(u32x2*)(ACT + (size_t)(tok0 + j) * FF + ca) = pk4(cv[j]);
        }
    } };
struct UpOrder { int G, c;
    DI bool next(int i, pg8::Unit2& u) const { pg8::StaticOrder so; so.init(MT, FF2, G, c); pg8::Unit t; if (!so.next(i, t)) return false; u.pm = t.pm; u.pn = t.pn; u.kt0 = 0; u.nt = D / 64; return true; }
};
DI void phase_conv_fix(const P& p, int bid, int G) {
    int tid = mk_tid(p.hi); unsigned char* ws = p.ws; const float* UX = (const float*)(ws + WS_UX); bf16_t* ACT = (bf16_t*)(ws + WS_ACT);
    for (int i = bid * 512 + tid; i < 32 * 4 * (FF / 4); i += G * 512) {
        const int c4 = (i % (FF / 4)) * 4, rr = i / (FF / 4), pm = rr >> 2, wr = (rr >> 1) & 1, j = rr & 1;
        f32x4 cv;
#pragma unroll
        for (int hf = 0; hf < 2; ++hf) { const int col = c4 + hf * FF;
            const f32x4 w0 = *(const f32x4*)(p.conv_w + col), w1 = *(const f32x4*)(p.conv_w + FF2 + col), w2 = *(const f32x4*)(p.conv_w + 2 * FF2 + col), cb = *(const f32x4*)(p.conv_b + col);
            const float* own = UX + ((size_t)pm * 8 + 4 + 2 * wr) * FF2 + col;
            const f32x4 zero = (f32x4){0.f, 0.f, 0.f, 0.f};
            f32x4 q7, q6;
            if (wr == 1) { q6 = *(const f32x4*)(UX + ((size_t)pm * 8 + 0) * FF2 + col); q7 = *(const f32x4*)(UX + ((size_t)pm * 8 + 1) * FF2 + col); }
            else if ((pm & 7) == 0) { q6 = zero; q7 = zero; }
            else { q6 = *(const f32x4*)(UX + ((size_t)(pm - 1) * 8 + 2) * FF2 + col); q7 = *(const f32x4*)(UX + ((size_t)(pm - 1) * 8 + 3) * FF2 + col); }
            const f32x4 u0 = *(const f32x4*)own, u1 = *(const f32x4*)(own + FF2);
            const f32x4 c = j == 0 ? cb + w2 * u0 + w1 * q7 + w0 * q6 : cb + w2 * u1 + w1 * u0 + w0 * q7;
            if (hf == 0) cv = silu4(c); else cv = cv * c; }
        *(u32x2*)(ACT + (size_t)(pm * 256 + wr * 128 + j) * FF + c4) = pk4(cv);
    }
}
struct EpiDown { static constexpr bool PERM = false, AFTER_DRAIN = false; const float* H; float* Y;
    DI void operator()(EPI_ARGS) const {
        const int row0 = u.pm * 256 + wr * 64 + fr, col0 = u.pn * 256 + wc * 32 + 4 * fq;
#pragma unroll
        for (int ai = 0; ai < 2; ++ai)
#pragma unroll
            for (int m = 0; m < 4; ++m) { const size_t o = (size_t)(row0 + ai * 128 + m * 16) * D + col0;
#pragma unroll
                for (int bj = 0; bj < 2; ++bj)
#pragma unroll
                    for (int n = 0; n < 2; ++n) *(f32x4*)(Y + o + bj * 128 + n * 16) = *(const f32x4*)(H + o + bj * 128 + n * 16) + acc[ai][bj][m][n]; }
    } };

typedef pg8::Unit2 Unit2;
#define EPI2_ARGS const f32x4 (&acc)[2][2][4][2], const Unit2& u, int wr, int wc, int fr, int fq
struct EpiDown2 { static constexpr bool PERM = false, AFTER_DRAIN = false; const float* H; float* Y; float* SLAB;
    DI void operator()(EPI2_ARGS) const {
        const int row0 = u.pm * 256 + wr * 64 + fr, col0 = u.pn * 256 + wc * 32 + 4 * fq; const bool whole = u.nt == FF / 64;
#pragma unroll
        for (int ai = 0; ai < 2; ++ai)
#pragma unroll
            for (int m = 0; m < 4; ++m) { const size_t o = (size_t)(row0 + ai * 128 + m * 16) * D + col0;
#pragma unroll
                for (int bj = 0; bj < 2; ++bj)
#pragma unroll
                    for (int n = 0; n < 2; ++n) { float* y = Y + o + bj * 128 + n * 16; const f32x4 a = acc[ai][bj][m][n];
                        if (whole) *(f32x4*)y = *(const f32x4*)(H + o + bj * 128 + n * 16) + a;
                        else *(f32x4*)(SLAB + (size_t)(2 * (u.kt0 / 22) + (u.kt0 % 22 ? 1 : 0)) * NS * D + (o - (size_t)NP * D) + bj * 128 + n * 16) = a; } }
    } };
struct DownOrder { int G, c;
    DI bool next(int i, Unit2& u) const { const long L = (long)i * G + c;
        if (L < 256) { pg8::StaticOrder so; so.init(NP, D, 1, (int)L); pg8::Unit t; so.next(0, t); u.pm = t.pm; u.pn = t.pn; u.kt0 = 0; u.nt = FF / 64; return true; }
        if (L < 512) { const int q = (int)L - 256, tile = q >> 3, ks = q & 7; u.pm = 32 + (tile >> 3); u.pn = tile & 7; u.kt0 = (ks >> 1) * 22 + (ks & 1) * 12; u.nt = (ks & 1) ? 10 : 12; return true; }
        return false; }
};
struct CmpOrder { int G, c;
    DI bool next(int i, Unit& u) const { const long L = (long)i * G + c; if (L >= 1056) return false; const int l = (int)L, pair = (l >> 4) * 8 + (l & 7), pn = (l >> 3) & 1, cc = pair / 264;
        u.pm = pair; u.pn = cc * 2 + pn; return true; }
    DI void a_ready(const Unit&) const {}
    DI void done(const Unit&) const {}
};


struct CmpOrderS { int G, c, l0, l1, skip;
    DI bool next(int i, pg8::Unit2& u) const { const int n = l1 - l0, full = n / G, rem = n - full * G, sk = (rem + skip <= G) ? skip : 0;
        int l; if (i < full) l = l0 + i * G + c; else if (i == full && c >= sk && c - sk < rem) l = l0 + full * G + c - sk; else return false;
        const int x = l & 7, pn = (l >> 3) & 1, q = (l >> 4) & 15, cc = (q >> 1) & 1, bb = (l >> 8) * 32 + (q >> 2) * 8 + x;
        u.pm = cc * 264 + 8 + bb * 2 + (q & 1); u.pn = cc * 2 + pn; u.kt0 = 0; u.nt = 16; return true; }
};
struct CmpOrderP { int G, c;
    DI bool next(int i, Unit& u) const { const long L = (long)i * G + c; if (L >= 32) return false; const int l = (int)L, cc = l >> 4, r = l & 15; u.pm = cc * 264 + (r >> 1); u.pn = cc * 2 + (r & 1); return true; }
    DI void a_ready(const Unit&) const {}
    DI void done(const Unit&) const {}
};
struct EpiHpre2 { static constexpr bool PERM = true, AFTER_DRAIN = false; bf16_t* Hp;
    DI void operator()(const f32x4 (&acc)[2][2][4][2], const pg8::Unit2& u, int wr, int wc, int fr, int fq) const { EpiHpre E{Hp}; Unit t; t.pm = u.pm; t.pn = u.pn; E(acc, t, wr, wc, fr, fq); } };
__global__ void __launch_bounds__(512, 2) k_all(P p_in) {
    extern __shared__ __attribute__((aligned(16))) unsigned char lds_raw[];
    LAS unsigned char* lds = (LAS unsigned char*)lds_raw;
    const int wave_u = __builtin_amdgcn_readfirstlane((int)(threadIdx.x >> 6)); const int lo = p_in.lo, hi = p_in.hi; P p = p_in; p.hi = wave_u;
    const int bid = blockIdx.x, G = gridDim.x;
    { const int tid = mk_tid(wave_u); if (tid < 64) ((LAS unsigned*)(lds + LDS_MISC))[tid] = 0u; }
    __syncthreads();
    XcdBarrier bar; bar.wave = wave_u; bar.bar = (unsigned*)(p.ws + CTL_BAR); bar.x = 0; bar.st = nullptr;
    if (hi - lo > 1) bar = xcd_barrier_post((unsigned*)(p.ws + CTL_BAR), (volatile LAS unsigned*)(lds + LDS_MISC), wave_u);
#ifndef MK_PH_MASK
#define MK_PH_MASK 0x7ff
#endif
#define IN(k) (lo <= (k) && (k) < hi && ((MK_PH_MASK >> (k)) & 1))
#define SEAM(k) do { if (IN(k) && IN((k) + 1)) xcd_barrier(bar); } while (0)
    unsigned char* ws = p.ws;
#ifndef MK_DUP
#define MK_DUP -1
#endif
#ifndef MK_DUPF
#define MK_DUPF -1
#endif
#define CALLF(id, ...) do { __VA_ARGS__; if (MK_DUPF == (id)) { __syncthreads(); __VA_ARGS__; } } while (0)
#define PHASE(k, ...) do { if (IN(k)) { __VA_ARGS__; if (MK_DUP == (k)) { xcd_barrier(bar); if ((k) == 0) { if (bid == 0) ((float*)(ws + CTL_PEB))[mk_tid(wave_u)] = 0.f; } if ((k) == 5) { for (int i = bid * 512 + mk_tid(wave_u); i < MT; i += G * 512) ((float*)(ws + CTL_ROWSS))[i] = 0.f; } xcd_barrier(bar); __VA_ARGS__; } } SEAM(k); } while (0)
    PHASE(0, phase_prologue(p, lds, bid, G));
    PHASE(1, {
        const int Gg = G > 243 ? 243 : G, cut = bid % 5, nuS = (G - Gg >= 13) ? 960 : 1024;
        pg8::Gemm g{(const bf16_t*)(ws + WS_XG), (const bf16_t*)(ws + WS_W1T), MT, DINP, D}; EpiProj E{(const float*)(ws + WS_RSTD1), (const float*)(ws + WS_SINCOS), p.out, ws};
        if (bid < Gg && cut > 0) { ProjOrder S{Gg, bid, 0, cut}; pg8::gemm_phase2<EpiProj, ProjOrder, true>(lds, g, S, E, wave_u); }
        __syncthreads(); phase_slice(p, lds, bid, G, 0, G > 227 ? I1 + I2 : I1 + I2 + I3); __syncthreads();
        if (bid < Gg) { ProjOrder S{Gg, bid, cut, 1 << 20}; pg8::gemm_phase2<EpiProj, ProjOrder, true>(lds, g, S, E, wave_u); }
        else if (nuS < 1024) { CmpOrderS SH{G - Gg, bid - Gg, nuS, 1024, 0}; EpiHpre2 EH{(bf16_t*)(ws + WS_HPRE)};
            pg8::gemm_phase_cmpA<EpiHpre2, CmpOrderS>(lds, p.cache_kv, p.page_table, (const bf16_t*)(ws + WS_WC1T), SH, EH, wave_u); } });
    PHASE(2, {
        if (bid & 1) { phase_ret_kv_mfma(p, bid, G); __syncthreads(); }
        if (G == 256) {
            __syncthreads();
            if (mk_tid(wave_u) == 0) { unsigned* c = (unsigned*)(ws + CTL_PAIR) + ((bid >> 4) * 8 + (bid & 7)); __hip_atomic_fetch_add(c, 1u, __ATOMIC_RELAXED, __HIP_MEMORY_SCOPE_AGENT);
                for (int spin = 0; spin < 100000 && __hip_atomic_load(c, __ATOMIC_RELAXED, __HIP_MEMORY_SCOPE_AGENT) < 2u; ++spin) __builtin_amdgcn_s_sleep(2); }
            __syncthreads(); }
        { const int nuS = (G - (G > 243 ? 243 : G) >= 13) ? 960 : 1024; CmpOrderS S{G, bid, 0, nuS, 32}; EpiHpre2 E{(bf16_t*)(ws + WS_HPRE)};
          pg8::gemm_phase_cmpA<EpiHpre2, CmpOrderS>(lds, p.cache_kv, p.page_table, (const bf16_t*)(ws + WS_WC1T), S, E, wave_u);
          pg8::Gemm g{(const bf16_t*)(ws + WS_CBU), (const bf16_t*)(ws + WS_WC1T), 2 * CM, 1024, 1024}; CmpOrderP SP{G, bid}; EpiHpre EP{(bf16_t*)(ws + WS_HPRE)};
          pg8::gemm_phase<EpiHpre, CmpOrderP, true, true>(lds, g, SP, EP, wave_u); }
        if (!(bid & 1)) { __syncthreads(); phase_ret_kv_mfma(p, bid, G); } });
    PHASE(3, { CALLF(30, phase_cmp_l2_mfma(p, lds, bid, G)); CALLF(31, phase_ret_scan_t(p, bid, G)); });
    PHASE(4, {
        if (bid & 1) { phase_attn_sample(p, lds, bid, G); __syncthreads(); phase_attn_prompt(p, lds, bid, G, 0, 1 << 20); } else { phase_attn_prompt(p, lds, bid, G, 0, 1 << 20); __syncthreads(); phase_attn_sample(p, lds, bid, G); }
        __syncthreads(); CALLF(42, phase_ret_out_mfma(p, lds, bid, G)); });
    PHASE(5, {
        pg8::Gemm g{(const bf16_t*)(ws + WS_MIX), (const bf16_t*)(ws + WS_W2T), MT, D, D}; OutOrder S{G, bid};
        EpiOut E{p.x_prompt, p.x_sample, p.g_ffn, (float*)(ws + WS_H), (bf16_t*)(ws + WS_HG), (float*)(ws + CTL_ROWSS), (float*)(ws + WS_SLAB)};
        pg8::gemm_phase2<EpiOut, OutOrder, false>(lds, g, S, E, wave_u); });
    PHASE(6, phase_out_reduce(p, bid, G));
    PHASE(7, {
        const int Gg = G > 227 ? 227 : G;
        if (bid < Gg) { pg8::Gemm g{(const bf16_t*)(ws + WS_HG), (const bf16_t*)(ws + WS_W3T), MT, FF2, D}; UpOrder S{Gg, bid};
            EpiUpConv E{(bf16_t*)(ws + WS_ACT), (const float*)(ws + CTL_ROWSS), p.conv_w, p.conv_b, p.state_conv, p.out, (float*)(ws + WS_UX)};
            pg8::gemm_phase2<EpiUpConv, UpOrder, true>(lds, g, S, E, wave_u); }
        if (G == Gg) phase_win_copy(p, bid, G); else if (bid >= Gg) { phase_slice(p, lds, bid - Gg, G - Gg, I1 + I2, I1 + I2 + I3); __syncthreads(); phase_win_copy(p, bid - Gg, G - Gg); } });
    PHASE(8, phase_conv_fix(p, bid, G));
    PHASE(9, {
        pg8::Gemm g{(const bf16_t*)(ws + WS_ACT), (const bf16_t*)(ws + WS_W4T), MT, D, FF}; DownOrder S{G, bid};
        EpiDown2 E{(const float*)(ws + WS_H), p.out + O_Y, (float*)(ws + WS_SLAB)};
        pg8::gemm_phase2<EpiDown2, DownOrder, false>(lds, g, S, E, wave_u); });
    PHASE(10, { const float* H = (const float*)(ws + WS_H) + (size_t)NP * D; const float* SL = (const float*)(ws + WS_SLAB); float* Y = p.out + O_Y + (size_t)NP * D;
        for (int i = bid * 512 + mk_tid(wave_u); i < NS * D / 4; i += 2 * G * 512) { const size_t o = (size_t)i * 4, o2 = o + (size_t)G * 2048; const bool two = i + G * 512 < NS * D / 4;
            f32x4 y = *(const f32x4*)(H + o), y2 = two ? *(const f32x4*)(H + o2) : y; f32x4 a[8], b[8];
            _Pragma("unroll") for (int k = 0; k < 8; ++k) { a[k] = *(const f32x4*)(SL + (size_t)k * NS * D + o); b[k] = two ? *(const f32x4*)(SL + (size_t)k * NS * D + o2) : a[k]; }
            _Pragma("unroll") for (int k = 0; k < 8; ++k) { y += a[k]; y2 += b[k]; }
            *(f32x4*)(Y + o) = y; if (two) *(f32x4*)(Y + o2) = y2; } });
#undef IN
#undef SEAM
}
}

#ifndef MK_N_LAUNCHES
#define MK_N_LAUNCHES 1
#endif
extern "C" void kernel_launch(void* const* d_in, const int* in_sizes, int n_in, void* d_out, int out_size, void* d_ws, size_t ws_size, hipStream_t stream) {
    using namespace mk;
    static int grid = 0;
    if (grid == 0) {
        if (n_in != 25 || (size_t)out_size != O_END || ws_size < WS_END) { fprintf(stderr, "kernel_launch: unexpected problem (n_in %d, out %d vs %zu, ws %zu vs %zu); nothing launched\n", n_in, out_size, (size_t)O_END, ws_size, (size_t)WS_END); grid = -1; return; }
        int dev = 0, cus = 0, per_cu = 0;
        if (hipGetDevice(&dev) != hipSuccess || hipDeviceGetAttribute(&cus, hipDeviceAttributeMultiprocessorCount, dev) != hipSuccess) { grid = -1; return; }
        if (hipFuncSetAttribute((const void*)k_all, hipFuncAttributeMaxDynamicSharedMemorySize, LDS_BYTES) != hipSuccess) { fprintf(stderr, "kernel_launch: hipFuncSetAttribute failed\n"); grid = -1; return; }
        if (hipOccupancyMaxActiveBlocksPerMultiprocessor(&per_cu, (const void*)k_all, 512, LDS_BYTES) != hipSuccess || per_cu < 1) { fprintf(stderr, "kernel_launch: occupancy query reports %d workgroups per CU\n", per_cu); (void)hipGetLastError(); grid = -1; return; }
        grid = cus;
    }
    if (grid < 0) return;
    (void)hipMemsetAsync((char*)d_ws + WS_CTL, 0, CTL_BYTES, stream);
    P p{};
    p.x_prompt = (const float*)d_in[0]; p.x_sample = (const float*)d_in[1]; p.cache_kv = (const float*)d_in[2]; p.cache_win = (const float*)d_in[3]; p.state_ret = (const float*)d_in[4];
    p.state_conv = (const float*)d_in[5]; p.page_table = (const int*)d_in[6]; p.g_attn = (const float*)d_in[7]; p.w_in = (const float*)d_in[8]; p.q_norm = (const float*)d_in[9];
    p.k_norm_cmp = (const float*)d_in[10]; p.k_norm_slc = (const float*)d_in[11]; p.k_norm_win = (const float*)d_in[12]; p.cmp_pe = (const float*)d_in[13]; p.cmp_w1 = (const float*)d_in[14];
    p.cmp_b1 = (const float*)d_in[15]; p.cmp_w2 = (const float*)d_in[16]; p.cmp_b2 = (const float*)d_in[17]; p.ret_gn = (const float*)d_in[18]; p.w_out = (const float*)d_in[19];
    p.g_ffn = (const float*)d_in[20]; p.w_up = (const float*)d_in[21]; p.conv_w = (const float*)d_in[22]; p.conv_b = (const float*)d_in[23]; p.w_down = (const float*)d_in[24];
    p.out = (float*)d_out; p.ws = (unsigned char*)d_ws;
    constexpr int NPH = 11;
    for (int li = 0; li < MK_N_LAUNCHES; ++li) {
        p.lo = (MK_N_LAUNCHES == 1) ? 0 : li; p.hi = (MK_N_LAUNCHES == 1) ? NPH : li + 1;
        hipLaunchKernelGGL(k_all, dim3(grid), dim3(512), LDS_BYTES, stream, p);
        const hipError_t le = hipPeekAtLastError();
        if (le != hipSuccess) { fprintf(stderr, "kernel_launch: launch %d failed: %s\n", li, hipGetErrorName(le)); break; }
    }
}
```
